# Optimizing an MI355X kernel written in HIP

```python
import math
import jax, jax.numpy as jnp
from jax import lax
import numpy as np

D_MODEL = 4096
BATCH = 1
SEQ = 8192
DEPTH = 1

MEM_LEN = 256
XA_HEADS = 4
XA_HEAD_DIM = 128
XA_WIDTH = XA_HEADS * XA_HEAD_DIM
SB_HEADS = 16
SB_HEAD_DIM = 128
SB_WIDTH = SB_HEADS * SB_HEAD_DIM
Q_BLOCK = 128
POOL_WINDOWS = (2, 4, 8, 16)
POOL_GROUPS = len(POOL_WINDOWS)
POOL_WIDTH = D_MODEL // 2
POOL_GROUP_DIM = POOL_WIDTH // POOL_GROUPS
IN_WIDTH = 3 * SB_WIDTH + POOL_WIDTH + 2 * D_MODEL
PEER_KEYS = 128
PEER_EXPERTS = PEER_KEYS * PEER_KEYS
PEER_HEADS = 8
PEER_QUERY_DIM = 256
PEER_HALF = PEER_QUERY_DIM // 2
PEER_TOPK = 16
PEER_CHUNK = 64
EPS = 1e-6

kernel_name = "hybrid_sba_pool_peer_block"


def rmsnorm(x, g):
    xf = x.astype(jnp.float32)
    y = xf * lax.rsqrt(jnp.mean(xf * xf, axis=-1, keepdims=True) + EPS)
    return (y * g.astype(jnp.float32)).astype(x.dtype)


def stick_breaking_attention(q, k, v):
    B, H, S, Dh = q.shape
    scale = Dh ** -0.5
    outs = []
    for blk in range(S // Q_BLOCK):
        t0 = blk * Q_BLOCK
        L = t0 + Q_BLOCK
        z = jnp.einsum('bhqd,bhkd->bhqk', q[:, :, t0:L], k[:, :, :L]).astype(jnp.float32) * scale
        t_idx = t0 + jnp.arange(Q_BLOCK)
        s_idx = jnp.arange(L)
        causal = s_idx[None, :] < t_idx[:, None]
        sp = jnp.where(causal, jax.nn.softplus(z), 0.0)
        between = lax.cumsum(sp, axis=3, reverse=True) - sp
        a = jnp.where(causal, jnp.exp(jax.nn.log_sigmoid(z) - between), 0.0)
        outs.append(jnp.einsum('bhqk,bhkd->bhqd', a.astype(v.dtype), v[:, :, :L]))
    return jnp.concatenate(outs, axis=2)


def multiscale_pool(u, w_groups, pool_scale):
    B, S, _ = u.shape
    ug = u.reshape(B, S, POOL_GROUPS, POOL_GROUP_DIM).astype(jnp.float32)
    cs = jnp.cumsum(ug, axis=1)
    pos = jnp.arange(S)
    outs = []
    for g, w in enumerate(POOL_WINDOWS):
        c = cs[:, :, g]
        lagged = jnp.pad(c, ((0, 0), (w, 0), (0, 0)))[:, :S]
        count = jnp.minimum(pos + 1, w).astype(jnp.float32)[None, :, None]
        outs.append((c - lagged) / count - ug[:, :, g])
    pooled = jnp.stack(outs, axis=2).astype(u.dtype)
    mixed = jnp.einsum('bsgc,gcd->bsgd', pooled, w_groups)
    return mixed.reshape(B, S, POOL_WIDTH) * pool_scale


def memory_cross_attention(h, mem_n, w_q, w_kv, w_o):
    B, S, _ = h.shape
    M = mem_n.shape[1]
    q = (h @ w_q).reshape(B, S, XA_HEADS, XA_HEAD_DIM)
    kv = (mem_n @ w_kv).reshape(B, M, 2, XA_HEADS, XA_HEAD_DIM)
    k, v = kv[:, :, 0], kv[:, :, 1]
    s = jnp.einsum('bqhd,bkhd->bhqk', q, k).astype(jnp.float32) * (XA_HEAD_DIM ** -0.5)
    p = jax.nn.softmax(s, axis=-1).astype(h.dtype)
    o = jnp.einsum('bhqk,bkhd->bqhd', p, v).reshape(B, S, XA_WIDTH)
    return o @ w_o


def peer_ffn(h, w_query, sub_keys, expert_down, expert_up):
    B, S, D = h.shape
    N = B * S
    tokens = h.reshape(N, D)
    q = (tokens @ w_query).reshape(N, PEER_HEADS, 2, PEER_HALF)
    scores = jnp.einsum('nhpc,hpkc->nhpk', q, sub_keys).astype(jnp.float32)
    s1, i1 = lax.top_k(scores[:, :, 0], PEER_TOPK)
    s2, i2 = lax.top_k(scores[:, :, 1], PEER_TOPK)
    cand = (s1[..., :, None] + s2[..., None, :]).reshape(N, PEER_HEADS, PEER_TOPK * PEER_TOPK)
    cand_id = (i1[..., :, None] * PEER_KEYS + i2[..., None, :]).reshape(N, PEER_HEADS, PEER_TOPK * PEER_TOPK)
    best, sel = lax.top_k(cand, PEER_TOPK)
    expert_id = jnp.take_along_axis(cand_id, sel, axis=-1)
    gate = jax.nn.softmax(best, axis=-1)
    n_chunks = N // PEER_CHUNK

    def chunk_fn(args):
        xc, idc, gc = args
        u = jnp.take(expert_down, idc, axis=0)
        act = jax.nn.gelu(jnp.einsum('chkd,cd->chk', u, xc).astype(jnp.float32), approximate=False)
        w = (gc * act).astype(xc.dtype)
        v = jnp.take(expert_up, idc, axis=0)
        return jnp.einsum('chk,chkd->cd', w, v)

    out = lax.map(chunk_fn, (tokens.reshape(n_chunks, PEER_CHUNK, D),
                             expert_id.reshape(n_chunks, PEER_CHUNK, PEER_HEADS, PEER_TOPK),
                             gate.reshape(n_chunks, PEER_CHUNK, PEER_HEADS, PEER_TOPK)))
    return out.reshape(B, S, D)


def setup_inputs(seed: int = 0) -> dict:
    key = jax.random.key(seed)
    ks = jax.random.split(key, 24)
    f32 = jnp.float32
    nrm = lambda k, shape, s: jax.random.normal(k, shape, f32) * s
    gain = lambda k, shape: 1.0 + 0.05 * jax.random.normal(k, shape, f32)
    L = DEPTH
    return {
        "x": nrm(ks[0], (BATCH, SEQ, D_MODEL), 1.0),
        "mem": nrm(ks[1], (BATCH, MEM_LEN, D_MODEL), 1.0),
        "norm_mix": gain(ks[2], (L, D_MODEL)),
        "norm_mem_q": gain(ks[3], (L, D_MODEL)),
        "norm_mem_kv": gain(ks[4], (L, D_MODEL)),
        "norm_ffn": gain(ks[5], (L, D_MODEL)),
        "norm_final": gain(ks[6], (D_MODEL,)),
        "w_in": nrm(ks[7], (L, D_MODEL, IN_WIDTH), D_MODEL ** -0.5),
        "pool_group_w": nrm(ks[8], (L, POOL_GROUPS, POOL_GROUP_DIM, POOL_GROUP_DIM), POOL_GROUP_DIM ** -0.5),
        "pool_scale": 0.5 + 0.1 * jax.random.normal(ks[9], (L, POOL_WIDTH), f32),
        "w_branch_sb": nrm(ks[10], (L, SB_WIDTH, D_MODEL), SB_WIDTH ** -0.5),
        "w_branch_pool": nrm(ks[11], (L, POOL_WIDTH, D_MODEL), POOL_WIDTH ** -0.5),
        "w_out": nrm(ks[12], (L, D_MODEL, D_MODEL), D_MODEL ** -0.5),
        "xa_w_q": nrm(ks[13], (L, D_MODEL, XA_WIDTH), D_MODEL ** -0.5),
        "xa_w_kv": nrm(ks[14], (L, D_MODEL, 2 * XA_WIDTH), D_MODEL ** -0.5),
        "xa_w_o": nrm(ks[15], (L, XA_WIDTH, D_MODEL), XA_WIDTH ** -0.5),
        "peer_w_query": nrm(ks[16], (L, D_MODEL, PEER_HEADS * PEER_QUERY_DIM), D_MODEL ** -0.5),
        "peer_sub_keys": nrm(ks[17], (L, PEER_HEADS, 2, PEER_KEYS, PEER_HALF), PEER_HALF ** -0.5),
        "peer_down": nrm(ks[18], (L, PEER_EXPERTS, D_MODEL), D_MODEL ** -0.5),
        "peer_up": nrm(ks[19], (L, PEER_EXPERTS, D_MODEL), PEER_HEADS ** -0.5),
    }


def reference(x, mem, norm_mix, norm_mem_q, norm_mem_kv, norm_ffn, norm_final, w_in, pool_group_w,
              pool_scale, w_branch_sb, w_branch_pool, w_out, xa_w_q, xa_w_kv, xa_w_o,
              peer_w_query, peer_sub_keys, peer_down, peer_up):
    B, S, _ = x.shape
    o_k = SB_WIDTH
    o_v = 2 * SB_WIDTH
    o_pool = 3 * SB_WIDTH
    o_gsb = o_pool + POOL_WIDTH
    o_gpool = o_gsb + D_MODEL
    for l in range(DEPTH):
        h = rmsnorm(x, norm_mix[l])
        proj = h @ w_in[l]
        to_heads = lambda t: t.reshape(B, S, SB_HEADS, SB_HEAD_DIM).transpose(0, 2, 1, 3)
        q = to_heads(proj[..., :o_k])
        k = to_heads(proj[..., o_k:o_v])
        v = to_heads(proj[..., o_v:o_pool])
        u_pool = proj[..., o_pool:o_gsb]
        g_sb = jax.nn.sigmoid(proj[..., o_gsb:o_gpool])
        g_pool = jax.nn.sigmoid(proj[..., o_gpool:])
        attn = stick_breaking_attention(q, k, v).transpose(0, 2, 1, 3).reshape(B, S, SB_WIDTH)
        y_sb = attn @ w_branch_sb[l]
        y_pool = multiscale_pool(u_pool, pool_group_w[l], pool_scale[l]) @ w_branch_pool[l]
        x = x + (g_sb * y_sb + g_pool * y_pool) @ w_out[l]
        mem_n = rmsnorm(mem, norm_mem_kv[l])
        x = x + memory_cross_attention(rmsnorm(x, norm_mem_q[l]), mem_n, xa_w_q[l], xa_w_kv[l], xa_w_o[l])
        x = x + peer_ffn(rmsnorm(x, norm_ffn[l]), peer_w_query[l], peer_sub_keys[l], peer_down[l], peer_up[l])
    return rmsnorm(x, norm_final)
```

```cpp
#include <hip/hip_runtime.h>
#include <cstdio>
#include <cstdint>


#ifndef PROBE_PHASE
#define PROBE_PHASE -1
#endif
#define PROBE_BEGIN(k) _Pragma("unroll 1") for (int rep_ = 0; rep_ < ((PROBE_PHASE == (k)) ? 2 : 1); ++rep_) {
#define PROBE_END }

#define LAS __attribute__((address_space(3)))
#define GAS __attribute__((address_space(1)))
typedef unsigned short bf16;
typedef short bf16x8 __attribute__((ext_vector_type(8)));
typedef short s16x4 __attribute__((ext_vector_type(4)));
typedef float f32x2 __attribute__((ext_vector_type(2)));
typedef float f32x4 __attribute__((ext_vector_type(4)));
typedef float f32x16 __attribute__((ext_vector_type(16)));
typedef unsigned u32x2 __attribute__((ext_vector_type(2)));
typedef unsigned u32x4 __attribute__((ext_vector_type(4)));
typedef unsigned u32x6 __attribute__((ext_vector_type(6)));
typedef float f32x32 __attribute__((ext_vector_type(32)));

constexpr int SEQ = 8192, DM = 4096, INW = 16384, SBW = 2048, PLW = 2048, NH = 16, HD = 128;
constexpr int MEML = 256, XAW = 512, XAH = 4;
constexpr int NEXP = 16384, PH = 8, PQW = 2048, PKEYS = 128, TOPK = 16;
constexpr float EPS = 1e-6f;
constexpr int ROW6 = DM * 6 / 8;
constexpr int ROW4 = DM / 2;
constexpr float LOG2E = 1.4426950408889634f, LN2 = 0.6931471805599453f;

constexpr size_t MiB = 1u << 20;
constexpr size_t WS_CTL = 0, CTL_BYTES = 2 * MiB;
constexpr size_t WS_WIN = 2 * MiB;
constexpr size_t WS_T = 2 * MiB, WS_GATED = 66 * MiB;
constexpr size_t WS_WSB = 130 * MiB, WS_WPOOL = 146 * MiB, WS_WOUT = 162 * MiB, WS_WXQ = 194 * MiB, WS_WKV = 198 * MiB, WS_WXO = 206 * MiB, WS_WPQ = 210 * MiB;
constexpr size_t WS_GW = 226 * MiB, WS_KEYS = 228 * MiB, WS_MEMN = 229 * MiB, WS_KVB = 231 * MiB;
constexpr size_t WS_DOWN4 = 232 * MiB, WS_DOWN6 = 264 * MiB, WS_UP4 = 360 * MiB, WS_UP6 = 392 * MiB;
constexpr size_t WS_UP2 = 824 * MiB, WS_SUP2 = 322 * MiB;
constexpr int ROW2 = DM / 4;
constexpr size_t WS_UP1 = 840 * MiB, WS_SUP1 = 323 * MiB;
constexpr int ROW1 = DM / 8;
constexpr size_t WS_SDOWN = 320 * MiB, WS_SUP = 321 * MiB;
constexpr size_t WS_H1 = 488 * MiB;
constexpr size_t WS_ATTN = 488 * MiB, WS_POOLED = 520 * MiB, WS_XB = 488 * MiB;
constexpr size_t WS_Q = 552 * MiB, WS_K = 584 * MiB, WS_VT = 616 * MiB, WS_UB = 648 * MiB, WS_GSB = 680 * MiB, WS_GPL = 744 * MiB;
constexpr size_t WS_MIXED = WS_Q, WS_PQ = WS_K, WS_EID = WS_VT, WS_GATE = WS_VT + 4 * MiB, WS_XQS = WS_GSB, WS_O = WS_GPL;
constexpr size_t WS_KVS = 808 * MiB, WS_END = 848 * MiB;
constexpr int CW_BAR = 4096;
constexpr size_t CTL_SS2 = 1 * MiB, CTL_SS3 = 1 * MiB + 64 * 1024;

constexpr int RING_BYTES = 131072;
constexpr int LDSCTL_OFF = 136 * 1024, MISC_OFF = LDSCTL_OFF + 320;
constexpr int LDS_BYTES = 147456;

#define LDS_WAIT() asm volatile("s_waitcnt lgkmcnt(0)" ::: "memory")
#define VM_WAIT() asm volatile("s_waitcnt vmcnt(0)" ::: "memory")
__device__ __forceinline__ int fresh_lane() { int l; asm volatile("v_mbcnt_lo_u32_b32 %0, -1, 0\n\tv_mbcnt_hi_u32_b32 %0, -1, %0" : "=v"(l)); return l; }
#define FRESH_IDS() const int lane = fresh_lane(); const int tid = wave * 64 + lane; (void)tid

__device__ __forceinline__ unsigned cvt_pk_bf16(float lo, float hi) { unsigned r; asm volatile("v_cvt_pk_bf16_f32 %0, %1, %2" : "=v"(r) : "v"(lo), "v"(hi)); return r; }
__device__ __forceinline__ float bf_lo(unsigned w) { return __builtin_bit_cast(float, w << 16); }
__device__ __forceinline__ float bf_hi(unsigned w) { return __builtin_bit_cast(float, w & 0xffff0000u); }
__device__ __forceinline__ float wave_sum(float v) {
#pragma unroll
    for (int o = 1; o < 64; o <<= 1) v += __shfl_xor(v, o);
    return v;
}
__device__ __forceinline__ u32x4 ld16(const void* sbase, unsigned voff, int imm = 0) { return *(const u32x4*)(((const char*)sbase + voff) + imm); }
__device__ __forceinline__ f32x4 ld16f(const void* sbase, unsigned voff, int imm = 0) { return *(const f32x4*)(((const char*)sbase + voff) + imm); }
__device__ __forceinline__ u32x2 ld8(const void* sbase, unsigned voff, int imm = 0) { return *(const u32x2*)(((const char*)sbase + voff) + imm); }
__device__ __forceinline__ float xchg32(float x, int hh) { const unsigned u = __builtin_bit_cast(unsigned, x); auto r = __builtin_amdgcn_permlane32_swap(u, u, false, false); return __builtin_bit_cast(float, hh ? r[0] : r[1]); }
__device__ __forceinline__ float xchg16(float x, int q) { const unsigned u = __builtin_bit_cast(unsigned, x); auto r = __builtin_amdgcn_permlane16_swap(u, u, false, false); return __builtin_bit_cast(float, q ? r[0] : r[1]); }
__device__ __forceinline__ float row_sum16(float v) {
    v += __builtin_bit_cast(float, __builtin_amdgcn_update_dpp(0, __builtin_bit_cast(int, v), 0x128, 0xf, 0xf, false));
    v += __builtin_bit_cast(float, __builtin_amdgcn_update_dpp(0, __builtin_bit_cast(int, v), 0x124, 0xf, 0xf, false));
    v += __builtin_bit_cast(float, __builtin_amdgcn_update_dpp(0, __builtin_bit_cast(int, v), 0x122, 0xf, 0xf, false));
    v += __builtin_bit_cast(float, __builtin_amdgcn_update_dpp(0, __builtin_bit_cast(int, v), 0x121, 0xf, 0xf, false));
    return v; }
__device__ __forceinline__ float wave_sum_x(float v, int lane) { v = row_sum16(v); v += xchg16(v, (lane >> 4) & 1); v += xchg32(v, lane >> 5); return v; }
__device__ __forceinline__ float wave_max_x(float v, int lane) {
    v = __builtin_fmaxf(v, __builtin_bit_cast(float, __builtin_amdgcn_update_dpp(0, __builtin_bit_cast(int, v), 0x128, 0xf, 0xf, false)));
    v = __builtin_fmaxf(v, __builtin_bit_cast(float, __builtin_amdgcn_update_dpp(0, __builtin_bit_cast(int, v), 0x124, 0xf, 0xf, false)));
    v = __builtin_fmaxf(v, __builtin_bit_cast(float, __builtin_amdgcn_update_dpp(0, __builtin_bit_cast(int, v), 0x122, 0xf, 0xf, false)));
    v = __builtin_fmaxf(v, __builtin_bit_cast(float, __builtin_amdgcn_update_dpp(0, __builtin_bit_cast(int, v), 0x121, 0xf, 0xf, false)));
    v = __builtin_fmaxf(v, xchg16(v, (lane >> 4) & 1)); v = __builtin_fmaxf(v, xchg32(v, lane >> 5)); return v; }
__device__ __forceinline__ float fexp2(float x) { return __builtin_amdgcn_exp2f(x); }
__device__ __forceinline__ float flog2(float x) { return __builtin_amdgcn_logf(x); }
__device__ __forceinline__ float frcp(float x) { return __builtin_amdgcn_rcpf(x); }

#define XB_TMO      128
#define XB_XCNT(j)  (256  + 64 * (j))
#define XB_XSUB(j)  (1280 + 64 * (j))
#define XB_XGEN(j)  (2304 + 64 * (j))
#define XB_TOP      3328
#define XB_TOPGEN   3392
#define XCD_BAR_WORDS 3456
#define XB_SPIN_CAP (1u << 18)
__device__ __forceinline__ unsigned xb_ld(unsigned* p)              { return __hip_atomic_load(p, __ATOMIC_RELAXED, __HIP_MEMORY_SCOPE_AGENT); }
__device__ __forceinline__ unsigned xb_add(unsigned* p, unsigned v) { return __hip_atomic_fetch_add(p, v, __ATOMIC_RELAXED, __HIP_MEMORY_SCOPE_AGENT); }
__device__ __forceinline__ unsigned xb_xcc_id() { return (unsigned)__builtin_amdgcn_s_getreg((3 << 11) | 20) & 0xFu; }
#define XB_SPIN(cond, bar) do { unsigned _sp = 0; while (cond) { __builtin_amdgcn_s_sleep(1); \
    if ((++_sp & 255u) == 0u) { if (xb_ld(&(bar)[XB_TMO])) break; if (_sp > XB_SPIN_CAP) { atomicAdd(&(bar)[XB_TMO], 1u); break; } } } } while (0)
struct XcdBarrier { unsigned* bar; unsigned x; volatile LAS unsigned* st; int wave; };
__device__ __forceinline__ XcdBarrier xcd_barrier_post(unsigned* bar, volatile LAS unsigned* st, int wave) {
    XcdBarrier b; b.bar = bar; b.x = xb_xcc_id(); b.st = st; b.wave = wave;
    if (threadIdx.x == 0) (void)xb_add(&bar[XB_XCNT(b.x)], 1u);
    return b;
}
__device__ __forceinline__ void xcd_barrier_complete(unsigned* bar, unsigned x, unsigned& nloc, unsigned& nx) {
    const unsigned G = gridDim.x * gridDim.y * gridDim.z;
    unsigned sum, cnt, mine, sp = 0u;
    for (;;) {
        sum = 0u; cnt = 0u; mine = 0u;
#pragma unroll
        for (unsigned j = 0; j < 16; ++j) { const unsigned c = xb_ld(&bar[XB_XCNT(j)]); sum += c; cnt += (c > 0u) ? 1u : 0u; mine = (j == x) ? c : mine; }
        if (sum == G) break;
        __builtin_amdgcn_s_sleep(1);
        if ((++sp & 255u) == 0u) { if (xb_ld(&bar[XB_TMO])) break; if (sp > XB_SPIN_CAP) { atomicAdd(&bar[XB_TMO], 1u); break; } }
    }
    nloc = mine > 0u ? mine : 1u; nx = cnt > 0u ? cnt : 1u;
}
__device__ __forceinline__ void xcd_barrier(const XcdBarrier& b) {
    asm volatile("s_waitcnt vmcnt(0)" ::: "memory");
    __syncthreads();
    if (b.wave == 0 && fresh_lane() == 0) {
        unsigned* bar = b.bar;
        __builtin_amdgcn_s_waitcnt(0);
        unsigned nloc = b.st[0], nx = b.st[1];
        if (nloc == 0u) { xcd_barrier_complete(bar, b.x, nloc, nx); b.st[0] = nloc; b.st[1] = nx; }
        const unsigned old = xb_add(&bar[XB_XSUB(b.x)], 1u);
        const unsigned gen = old / nloc;
        if (old + 1u == (gen + 1u) * nloc) {
            __builtin_amdgcn_fence(__ATOMIC_RELEASE, "agent");
            asm volatile("s_waitcnt vmcnt(0)" ::: "memory");
            const unsigned og = xb_add(&bar[XB_TOP], 1u);
            const unsigned tg = og / nx;
            if (og + 1u == (tg + 1u) * nx) xb_add(&bar[XB_TOPGEN], 1u);
            else XB_SPIN(xb_ld(&bar[XB_TOPGEN]) == tg, bar);
            __builtin_amdgcn_fence(__ATOMIC_ACQUIRE, "agent");
            xb_add(&bar[XB_XGEN(b.x)], 1u);
            asm volatile("s_waitcnt vmcnt(0)" ::: "memory");
        } else {
            XB_SPIN(xb_ld(&bar[XB_XGEN(b.x)]) == gen, bar);
            __builtin_amdgcn_fence(__ATOMIC_ACQUIRE, "agent");
            asm volatile("s_waitcnt vmcnt(0)" ::: "memory");
        }
    }
    __syncthreads();
}

namespace pg8 {
constexpr int BM = 256, BK = 64, HALF = 128, HTB = HALF * BK * 2, STAGE_BYTES = 8 * HTB, NXCD = 8, WGM = 8;
__host__ __device__ __forceinline__ int lds_byte(int r, int c) { const int st = (r >> 4) * 2 + (c >> 5), rr = r & 15, cc = c & 31, ob = rr * 64 + cc * 2; return st * 1024 + (ob ^ (((ob >> 9) & 1) << 5)); }
__host__ __device__ __forceinline__ void stage_rc(int b, int& R, int& C) { const int st = b / 1024, sb = b % 1024, swz = sb ^ (((sb >> 9) & 1) << 5); R = (st >> 1) * 16 + swz / 64; C = (st & 1) * 32 + (swz % 64) / 2; }
__host__ __device__ __forceinline__ int perm32(int rho) { const int n = rho >> 4, i = rho & 15; return 8 * (i >> 2) + 4 * n + (i & 3); }

typedef int i32x8 __attribute__((ext_vector_type(8))); typedef int i32x4 __attribute__((ext_vector_type(4)));
__device__ __forceinline__ i32x8 cat8(const bf16x8 lo, const bf16x8 hi) { const i32x4 a = __builtin_bit_cast(i32x4, lo), b = __builtin_bit_cast(i32x4, hi); return __builtin_shufflevector(a, b, 0, 1, 2, 3, 4, 5, 6, 7); }
struct GUnit { int pm, pn, ks; size_t aoff, boff; };
struct Gemm { const bf16* A; const bf16* Bt; int lda, ldb, K; };

template <int MODE> struct Order {
    int nM, nN, nKs, nwg, G, c; size_t a_pm, a_ks, b_pn, b_ks;
    __device__ __forceinline__ void init(int nM_, int nN_, int nKs_, int G_, int c_, size_t a_pm_, size_t a_ks_, size_t b_pn_, size_t b_ks_) {
        nM = nM_; nN = nN_; nKs = nKs_; nwg = nM * nN; G = G_; c = c_; a_pm = a_pm_; a_ks = a_ks_; b_pn = b_pn_; b_ks = b_ks_; }
    __device__ __forceinline__ bool next(int i, GUnit& u) const {
        const long L = (long)i * G + c; if (L >= (long)nwg * nKs) return false;
        const int ks = (int)(L / nwg); int wgid = (int)(L % nwg);
        { const int q = nwg / NXCD, r = nwg % NXCD, xcd = wgid % NXCD, off = wgid / NXCD; wgid = (xcd < r ? xcd * (q + 1) : r * (q + 1) + (xcd - r) * q) + off; }
        const int nig = WGM * nN, gid = wgid / nig, fm = gid * WGM, gsz = (nM - fm) < WGM ? (nM - fm) : WGM;
        int pm = fm + ((wgid % nig) % gsz), pn = (wgid % nig) / gsz;
        if (MODE == 1) pn = pn < 16 ? pn : pn + 8;
        u.pm = pm; u.pn = pn; u.ks = ks;
        u.aoff = (size_t)pm * a_pm + (size_t)ks * a_ks + (MODE == 2 ? (size_t)(pn >> 1) * 1024 : 0);
        u.boff = (size_t)pn * b_pn + (size_t)ks * b_ks;
        return true;
    }
    __device__ __forceinline__ void a_ready(const GUnit&) const {}
    __device__ __forceinline__ void done(const GUnit&) const {}
};

template <class Epi, class Sched, bool FP8 = false, bool ALIGN_EPI = true, bool SP2 = true>
__device__ __forceinline__ void gemm_phase(LAS unsigned char* lds, const Gemm g, const Sched& S, const Epi& E, const int wave_id) {
    const int lane = fresh_lane(), wid = wave_id, tid = wid * 64 + lane, wr = wid >> 2, wc = wid & 3, fr = lane & 15, fq = lane >> 4;
    const int K = g.K, nt = K / BK;
    unsigned voffA[2], voffB[2];
#pragma unroll
    for (int i = 0; i < 2; ++i) { int R, C; stage_rc(tid * 16 + i * 8192, R, C); const int Rb = (R & ~31) + perm32(R & 31);
        voffA[i] = (unsigned)(R * g.lda + C) * 2u; voffB[i] = (unsigned)(Rb * g.ldb + C) * 2u; }
    const size_t kstep = (size_t)(BK * 2);
    const size_t hstepA = (size_t)HALF * g.lda * 2, hstepB = (size_t)HALF * g.ldb * 2;
    const unsigned ldsw = (unsigned)wid * 1024u;
    const int aoff = lds_byte(wr * 64 + fr, fq * 8), boff = lds_byte(wc * 32 + fr, fq * 8);
#define PG8_SA(b, h) (((b) * 2 + (h)) * HTB)
#define PG8_SB(b, h) ((4 + (b) * 2 + (h)) * HTB)
#define PG8_STAGE(bufoff, gbase, voff) do { _Pragma("unroll") for (int _i = 0; _i < 2; ++_i) \
        __builtin_amdgcn_global_load_lds((const unsigned*)((const char*)(gbase) + (voff)[_i]), (LAS unsigned*)(lds + (bufoff) + ldsw + _i * 8192), 16, 0, 0); } while (0)
#define PG8_LD16(off) (*(const LAS bf16x8*)(lds + (off)))
#define PG8_LDA(dst, b, h) do { _Pragma("unroll") for (int m = 0; m < 4; ++m) { if constexpr (FP8) dst##8[m] = cat8(PG8_LD16(PG8_SA(b, h) + aoff + m * 2048), PG8_LD16(PG8_SA(b, h) + aoff + m * 2048 + 1024)); \
        else { _Pragma("unroll") for (int k = 0; k < 2; ++k) dst[m][k] = PG8_LD16(PG8_SA(b, h) + aoff + m * 2048 + k * 1024); } } } while (0)
#define PG8_LDB(dst, b, h) do { _Pragma("unroll") for (int n = 0; n < 2; ++n) { if constexpr (FP8) dst##8[n] = cat8(PG8_LD16(PG8_SB(b, h) + boff + n * 2048), PG8_LD16(PG8_SB(b, h) + boff + n * 2048 + 1024)); \
        else { _Pragma("unroll") for (int k = 0; k < 2; ++k) dst[n][k] = PG8_LD16(PG8_SB(b, h) + boff + n * 2048 + k * 1024); } } } while (0)
#define PG8_MMA(ai, bj, At, Bt) do { __builtin_amdgcn_s_setprio(1); _Pragma("unroll") for (int m = 0; m < 4; ++m) _Pragma("unroll") for (int n = 0; n < 2; ++n) { \
        if constexpr (FP8) asm volatile("v_mfma_scale_f32_16x16x128_f8f6f4 %0, %1, %2, %0, %3, %3 op_sel_hi:[0,0,0]" : "+v"(acc[ai][bj][m][n]) : "v"(Bt##8[n]), "v"(At##8[m]), "v"(one_scale)); \
        else { _Pragma("unroll") for (int k = 0; k < 2; ++k) acc[ai][bj][m][n] = __builtin_amdgcn_mfma_f32_16x16x32_bf16(Bt[n][k], At[m][k], acc[ai][bj][m][n], 0, 0, 0); } } __builtin_amdgcn_s_setprio(0); } while (0)
#define PG8_WAIT_V(n) asm volatile("s_waitcnt vmcnt(" #n ")" ::: "memory")
#define PG8_WAIT_L(n) asm volatile("s_waitcnt lgkmcnt(" #n ")" ::: "memory")
#define PG8_BAR __builtin_amdgcn_s_barrier()
#define PG8_SCHED __builtin_amdgcn_sched_barrier(0)
    GUnit cur, nxt; int ui = 0;
    if (!S.next(0, cur)) return;
    f32x4 acc[2][2][4][2];
#pragma unroll
    for (int a = 0; a < 2; ++a)
#pragma unroll
        for (int b = 0; b < 2; ++b)
#pragma unroll
            for (int m = 0; m < 4; ++m)
#pragma unroll
                for (int n = 0; n < 2; ++n) acc[a][b][m][n] = (f32x4){0.f, 0.f, 0.f, 0.f};
    const int one_scale = 0x7f7f7f7f;
    bf16x8 At[4][2], B0[2][2], B1[2][2]; i32x8 At8[4], B08[2], B18[2];
    const char* cA = (const char*)g.A + cur.aoff; const char* cB = (const char*)g.Bt + cur.boff;
    S.a_ready(cur);
    if constexpr (SP2) {
        PG8_STAGE(PG8_SB(0, 0), cB, voffB); PG8_STAGE(PG8_SB(0, 1), cB + hstepB, voffB); PG8_STAGE(PG8_SA(0, 0), cA, voffA); PG8_STAGE(PG8_SA(0, 1), cA + hstepA, voffA);
        if (wr == 1) PG8_BAR;
        PG8_WAIT_V(2); PG8_BAR;
        PG8_STAGE(PG8_SB(1, 0), cB + kstep, voffB); PG8_STAGE(PG8_SA(1, 0), cA + kstep, voffA); PG8_STAGE(PG8_SB(1, 1), cB + hstepB + kstep, voffB);
        PG8_WAIT_V(6); PG8_BAR;
    } else {
        PG8_STAGE(PG8_SB(0, 0), cB, voffB); PG8_STAGE(PG8_SA(0, 0), cA, voffA); PG8_STAGE(PG8_SB(0, 1), cB + hstepB, voffB); PG8_STAGE(PG8_SA(0, 1), cA + hstepA, voffA);
        if (wr == 1) PG8_BAR;
        PG8_WAIT_V(4); PG8_BAR;
        PG8_STAGE(PG8_SB(1, 0), cB + kstep, voffB); PG8_STAGE(PG8_SA(1, 0), cA + kstep, voffA); PG8_STAGE(PG8_SB(1, 1), cB + hstepB + kstep, voffB);
        PG8_WAIT_V(6); PG8_BAR;
    }
    for (;;) {
        const bool has_next = S.next(ui + 1, nxt);
        const char* nA = has_next ? (const char*)g.A + nxt.aoff : cA; const char* nB = has_next ? (const char*)g.Bt + nxt.boff : cB;
        for (int t = 0; t < nt; t += 2) {
            const bool last = (t == nt - 2);
            const char* a1 = cA + (size_t)(t + 1) * kstep;
            const char* a2 = last ? nA : cA + (size_t)(t + 2) * kstep; const char* b2 = last ? nB : cB + (size_t)(t + 2) * kstep;
            const char* a3 = a2 + kstep; const char* b3 = b2 + kstep;
            if (last && has_next) S.a_ready(nxt);
            if constexpr (SP2) {
            PG8_LDB(B0, 0, 0); PG8_LDB(B1, 0, 1); PG8_SCHED; PG8_LDA(At, 0, 0); PG8_STAGE(PG8_SA(1, 1), a1 + hstepA, voffA);
            PG8_WAIT_V(8); PG8_WAIT_L(0); PG8_BAR; PG8_MMA(0, 0, At, B0); PG8_MMA(0, 1, At, B1); PG8_BAR; PG8_SCHED;
            PG8_LDA(At, 0, 1); PG8_STAGE(PG8_SB(0, 0), b2, voffB); PG8_STAGE(PG8_SB(0, 1), b2 + hstepB, voffB); PG8_STAGE(PG8_SA(0, 0), a2, voffA);
            PG8_WAIT_V(8); PG8_WAIT_L(0); PG8_BAR; PG8_MMA(1, 0, At, B0); PG8_MMA(1, 1, At, B1); PG8_BAR; PG8_SCHED;
            PG8_LDB(B0, 1, 0); PG8_LDB(B1, 1, 1); PG8_SCHED; PG8_LDA(At, 1, 0); PG8_STAGE(PG8_SA(0, 1), a2 + hstepA, voffA);
            PG8_WAIT_V(8); PG8_WAIT_L(0); PG8_BAR; PG8_MMA(0, 0, At, B0); PG8_MMA(0, 1, At, B1); PG8_BAR; PG8_SCHED;
            PG8_LDA(At, 1, 1); PG8_STAGE(PG8_SB(1, 0), b3, voffB); PG8_STAGE(PG8_SB(1, 1), b3 + hstepB, voffB); PG8_STAGE(PG8_SA(1, 0), a3, voffA);
            PG8_WAIT_V(8); PG8_WAIT_L(0); PG8_BAR; PG8_MMA(1, 0, At, B0); PG8_MMA(1, 1, At, B1); PG8_BAR; PG8_SCHED;
            } else {
            PG8_LDB(B0, 0, 0); PG8_SCHED; PG8_LDA(At, 0, 0); PG8_STAGE(PG8_SA(1, 1), a1 + hstepA, voffA);
            PG8_WAIT_L(8); PG8_BAR; PG8_WAIT_L(0); PG8_MMA(0, 0, At, B0); PG8_BAR; PG8_SCHED;
            PG8_LDB(B1, 0, 1); PG8_STAGE(PG8_SB(0, 0), b2, voffB);
            PG8_BAR; PG8_WAIT_L(0); PG8_MMA(0, 1, At, B1); PG8_BAR;
            PG8_LDA(At, 0, 1); PG8_STAGE(PG8_SA(0, 0), a2, voffA);
            PG8_BAR; PG8_WAIT_L(0); PG8_MMA(1, 0, At, B0); PG8_BAR; PG8_SCHED;
            PG8_STAGE(PG8_SB(0, 1), b2 + hstepB, voffB);
            PG8_WAIT_V(6); PG8_BAR; PG8_MMA(1, 1, At, B1); PG8_BAR;
            PG8_LDB(B0, 1, 0); PG8_SCHED; PG8_LDA(At, 1, 0); PG8_STAGE(PG8_SA(0, 1), a2 + hstepA, voffA);
            PG8_WAIT_L(8); PG8_BAR; PG8_WAIT_L(0); PG8_MMA(0, 0, At, B0); PG8_BAR; PG8_SCHED;
            PG8_LDB(B1, 1, 1); PG8_STAGE(PG8_SB(1, 0), b3, voffB);
            PG8_BAR; PG8_WAIT_L(0); PG8_MMA(0, 1, At, B1); PG8_BAR;
            PG8_LDA(At, 1, 1); PG8_STAGE(PG8_SA(1, 0), a3, voffA);
            PG8_BAR; PG8_WAIT_L(0); PG8_MMA(1, 0, At, B0); PG8_BAR; PG8_SCHED;
            PG8_STAGE(PG8_SB(1, 1), b3 + hstepB, voffB);
            PG8_WAIT_V(6); PG8_BAR; PG8_MMA(1, 1, At, B1); PG8_BAR;
            }
        }
        if constexpr (ALIGN_EPI) { if (wr == 0) PG8_BAR; }
        if constexpr (FP8) asm volatile("s_nop 15\n\ts_nop 15\n\ts_nop 15" ::: "memory");
        { const int l_e = fresh_lane();
          E(acc, cur, wr, wc, l_e & 15, l_e >> 4); } S.done(cur);
        if (!has_next) break;
#pragma unroll
        for (int a = 0; a < 2; ++a)
#pragma unroll
            for (int b = 0; b < 2; ++b)
#pragma unroll
                for (int m = 0; m < 4; ++m)
#pragma unroll
                    for (int n = 0; n < 2; ++n) acc[a][b][m][n] = (f32x4){0.f, 0.f, 0.f, 0.f};
        cur = nxt; cA = nA; cB = nB; ++ui;
        if constexpr (ALIGN_EPI) { if (wr == 1) PG8_BAR; }
    }
    PG8_WAIT_V(0);
    if constexpr (!ALIGN_EPI) { if (wr == 0) PG8_BAR; }
    PG8_BAR;
#undef PG8_SA
#undef PG8_SB
#undef PG8_STAGE
#undef PG8_LDA
#undef PG8_LDB
#undef PG8_MMA
#undef PG8_WAIT_V
#undef PG8_WAIT_L
#undef PG8_BAR
#undef PG8_SCHED
}

#define EPI_LOOP_ROWS for (int ai = 0; ai < 2; ++ai) _Pragma("unroll") for (int m = 0; m < 4; ++m)
__device__ __forceinline__ u32x4 pack8(const f32x4 v0, const f32x4 v1) { u32x4 w; w.x = cvt_pk_bf16(v0[0], v0[1]); w.y = cvt_pk_bf16(v0[2], v0[3]); w.z = cvt_pk_bf16(v1[0], v1[1]); w.w = cvt_pk_bf16(v1[2], v1[3]); return w; }
__device__ __forceinline__ void unpack8(const u32x4 w, f32x4& v0, f32x4& v1) { v0 = (f32x4){bf_lo(w.x), bf_hi(w.x), bf_lo(w.y), bf_hi(w.y)}; v1 = (f32x4){bf_lo(w.z), bf_hi(w.z), bf_lo(w.w), bf_hi(w.w)}; }
__device__ __forceinline__ f32x4 sigmoid4(const f32x4 v) { f32x4 r;
#pragma unroll
    for (int j = 0; j < 4; ++j) r[j] = frcp(1.0f + fexp2(-v[j] * LOG2E));
    return r; }

struct EpiInProj {
    bf16 *qb, *kb, *ub, *gsb, *gpl; float sc;
    __device__ __forceinline__ void operator()(const f32x4 (&acc)[2][2][4][2], const GUnit& u, int wr, int wc, int fr, int fq) const {
        const int pn = u.pn; bf16* base; int ldc, ct; bool sig = false;
        if (pn < 8) { base = qb; ldc = SBW; ct = pn; }
        else if (pn < 16) { base = kb; ldc = SBW; ct = pn - 8; }
        else if (pn < 32) { base = ub; ldc = PLW; ct = pn - 24; }
        else if (pn < 48) { base = gsb; ldc = DM; ct = pn - 32; sig = true; }
        else { base = gpl; ldc = DM; ct = pn - 48; sig = true; }
        const int row0 = u.pm * BM + wr * 64 + fr, col0 = ct * BM + wc * 32 + 8 * fq;
#pragma unroll
        EPI_LOOP_ROWS { bf16* rowp = base + (size_t)(row0 + ai * HALF + m * 16) * ldc + col0;
#pragma unroll
            for (int bj = 0; bj < 2; ++bj) { f32x4 v0 = acc[ai][bj][m][0] * sc, v1 = acc[ai][bj][m][1] * sc;
                if (sig) { v0 = sigmoid4(v0); v1 = sigmoid4(v1); }
                *(u32x4*)(rowp + bj * HALF) = pack8(v0, v1); } }
    }
};
template <int KIND> struct EpiB {
    bf16* O; int ldc; const float* ss; const bf16* g1; const bf16* t; float sc; float osc = 1.0f;
    __device__ __forceinline__ void operator()(const f32x4 (&acc)[2][2][4][2], const GUnit& u, int wr, int wc, int fr, int fq) const {
        const int row0 = u.pm * BM + wr * 64 + fr, col0 = u.pn * BM + wc * 32 + 8 * fq;
#pragma unroll
        EPI_LOOP_ROWS { const int row = row0 + ai * HALF + m * 16; const size_t off = (size_t)row * ldc + col0;
            float rs = 1.f; if (KIND == 1) rs = __builtin_amdgcn_rsqf(ss[row] * (1.0f / DM) + EPS);
#pragma unroll
            for (int bj = 0; bj < 2; ++bj) { f32x4 v0 = acc[ai][bj][m][0], v1 = acc[ai][bj][m][1];
                if (KIND == 0 || KIND == 2 || KIND == 3 || KIND == 4 || KIND == 5) { v0 = v0 * sc; v1 = v1 * sc; }
                if (KIND == 1) { v0 = v0 * rs; v1 = v1 * rs; }
                if (KIND == 2 || KIND == 3 || KIND == 5) { f32x4 a0, a1; unpack8(*(const u32x4*)(g1 + off + bj * HALF), a0, a1); v0 = v0 * a0; v1 = v1 * a1; }
                if (KIND == 3 || KIND == 5) { f32x4 a0, a1; unpack8(*(const u32x4*)(t + off + bj * HALF), a0, a1); v0 = v0 + a0; v1 = v1 + a1; }
                if (KIND == 5) { v0 = v0 * osc; v1 = v1 * osc; }
                if (KIND == 4 || KIND == 5) { int p0 = 0, p1 = 0; p0 = __builtin_amdgcn_cvt_pk_fp8_f32(v0[0], v0[1], p0, false); p0 = __builtin_amdgcn_cvt_pk_fp8_f32(v0[2], v0[3], p0, true); p1 = __builtin_amdgcn_cvt_pk_fp8_f32(v1[0], v1[1], p1, false); p1 = __builtin_amdgcn_cvt_pk_fp8_f32(v1[2], v1[3], p1, true);
                    *(u32x2*)((unsigned char*)O + off + bj * HALF) = (u32x2){(unsigned)p0, (unsigned)p1}; }
                else *(u32x4*)(O + off + bj * HALF) = pack8(v0, v1); } }
    }
};
struct EpiSlab {
    float* slab; int ldc; size_t slab_stride;
    __device__ __forceinline__ void operator()(const f32x4 (&acc)[2][2][4][2], const GUnit& u, int wr, int wc, int fr, int fq) const {
        const int row0 = u.pm * BM + wr * 64 + fr, col0 = u.pn * BM + wc * 32 + 8 * fq; float* base = slab + (size_t)u.ks * slab_stride;
#pragma unroll
        EPI_LOOP_ROWS { float* rowp = base + (size_t)(row0 + ai * HALF + m * 16) * ldc + col0;
#pragma unroll
            for (int bj = 0; bj < 2; ++bj) { *(f32x4*)(rowp + bj * HALF) = acc[ai][bj][m][0]; *(f32x4*)(rowp + bj * HALF + 4) = acc[ai][bj][m][1]; } }
    }
};
template <bool BASE_BF16> struct EpiRes {
    const float* base32; const bf16* base16; bf16* xb; float* ss; float sc = 1.0f;
    __device__ __forceinline__ void operator()(const f32x4 (&acc)[2][2][4][2], const GUnit& u, int wr, int wc, int fr, int fq) const {
        const int row0 = u.pm * BM + wr * 64 + fr, col0 = u.pn * BM + wc * 32 + 8 * fq;
#pragma unroll
        EPI_LOOP_ROWS { const int row = row0 + ai * HALF + m * 16; const size_t off = (size_t)row * DM + col0; float sq = 0.f;
#pragma unroll
            for (int bj = 0; bj < 2; ++bj) { f32x4 b0, b1;
                if (BASE_BF16) unpack8(*(const u32x4*)(base16 + off + bj * HALF), b0, b1); else { b0 = *(const f32x4*)(base32 + off + bj * HALF); b1 = *(const f32x4*)(base32 + off + bj * HALF + 4); }
                const f32x4 v0 = acc[ai][bj][m][0] * sc + b0, v1 = acc[ai][bj][m][1] * sc + b1;
                *(u32x4*)(xb + off + bj * HALF) = pack8(v0, v1);
                sq += (v0[0] * v0[0] + v0[1] * v0[1]) + (v0[2] * v0[2] + v0[3] * v0[3]) + (v1[0] * v1[0] + v1[1] * v1[1]) + (v1[2] * v1[2] + v1[3] * v1[3]); }
            sq += __shfl_xor(sq, 16); sq += __shfl_xor(sq, 32);
            if (fq == 0) unsafeAtomicAdd(ss + row, sq); }
    }
};
}

struct Params {
    const float *x, *mem, *norm_mix, *norm_mem_q, *norm_mem_kv, *norm_ffn, *norm_final, *w_in, *pool_group_w, *pool_scale, *w_branch_sb, *w_branch_pool, *w_out,
                *xa_w_q, *xa_w_kv, *xa_w_o, *peer_w_query, *peer_sub_keys, *peer_down, *peer_up;
    float* out; unsigned char* ws;
};

__device__ __forceinline__ void p0_transpose_item(const float* W, int N, bf16* WT, int ldt, const float* gk, const float* sn, LAS float* scr, int item, int lane) {
    const int nblk = N / 64, kb = item / nblk, nb = item % nblk, k0 = 64 * kb, n0 = 64 * nb;
    { float t_[64];
#pragma unroll
      for (int kk = 0; kk < 64; ++kk) t_[kk] = W[(size_t)(k0 + kk) * N + n0 + lane];
#pragma unroll
      for (int kk = 0; kk < 64; ++kk) scr[kk * 65 + lane] = t_[kk]; }
    LDS_WAIT(); asm volatile("" ::: "memory");
    const int c = lane & 7;
    float g[8];
#pragma unroll
    for (int j = 0; j < 8; ++j) g[j] = gk ? gk[k0 + 8 * c + j] : 1.f;
#pragma unroll
    for (int jj = 0; jj < 8; ++jj) { const int n = (lane >> 3) + 8 * jj; const LAS float* s = scr + (8 * c) * 65 + n; const float sc = sn ? sn[n0 + n] : 1.f;
        u32x4 o; o.x = cvt_pk_bf16(s[0 * 65] * g[0] * sc, s[1 * 65] * g[1] * sc); o.y = cvt_pk_bf16(s[2 * 65] * g[2] * sc, s[3 * 65] * g[3] * sc);
        o.z = cvt_pk_bf16(s[4 * 65] * g[4] * sc, s[5 * 65] * g[5] * sc); o.w = cvt_pk_bf16(s[6 * 65] * g[6] * sc, s[7 * 65] * g[7] * sc);
        *(u32x4*)(WT + (size_t)(n0 + n) * ldt + k0 + 8 * c) = o; }
    LDS_WAIT(); asm volatile("" ::: "memory");
}
__device__ __forceinline__ void p0_transpose_item_f8(const float* W, int N, unsigned char* WT, int ldt, float scl, LAS float* scr, int item, int lane) {
    const int nblk = N / 64, kb = item / nblk, nb = item % nblk, k0 = 64 * kb, n0 = 64 * nb;
    { float t_[64];
#pragma unroll
      for (int kk = 0; kk < 64; ++kk) t_[kk] = W[(size_t)(k0 + kk) * N + n0 + lane];
#pragma unroll
      for (int kk = 0; kk < 64; ++kk) scr[kk * 65 + lane] = t_[kk]; }
    LDS_WAIT(); asm volatile("" ::: "memory");
    const int c = lane & 3;
#pragma unroll
    for (int jj = 0; jj < 4; ++jj) { const int n = (lane >> 2) + 16 * jj; const LAS float* sp = scr + (16 * c) * 65 + n; u32x4 o;
#pragma unroll
        for (int q = 0; q < 4; ++q) { int pk = 0; pk = __builtin_amdgcn_cvt_pk_fp8_f32(sp[(4 * q) * 65] * scl, sp[(4 * q + 1) * 65] * scl, pk, false); pk = __builtin_amdgcn_cvt_pk_fp8_f32(sp[(4 * q + 2) * 65] * scl, sp[(4 * q + 3) * 65] * scl, pk, true); o[q] = (unsigned)pk; }
        *(u32x4*)(WT + (size_t)(n0 + n) * ldt + k0 + 16 * c) = o; }
    LDS_WAIT(); asm volatile("" ::: "memory");
}
__device__ __forceinline__ void p0_tile128_load(const float* W, int N, int k0, int n0, LAS float* scr, int lane) {
    const int r2 = lane >> 5, cc = lane & 31;
    { float t_[64];
#pragma unroll
      for (int kk = 0; kk < 64; ++kk) t_[kk] = W[(size_t)(k0 + 2 * kk + r2) * N + n0 + cc];
#pragma unroll
      for (int kk = 0; kk < 64; ++kk) scr[(2 * kk + r2) * 33 + cc] = t_[kk]; }
    LDS_WAIT(); asm volatile("" ::: "memory");
}
__device__ __forceinline__ void p0_transpose_item128(const float* W, int N, bf16* WT, int ldt, const float* gk, const float* sn, LAS float* scr, int item, int lane) {
    const int nblk = N / 32, kb = item / nblk, nb = item % nblk, k0 = 128 * kb, n0 = 32 * nb;
    p0_tile128_load(W, N, k0, n0, scr, lane);
    const int c = lane >> 2;
    float g[8];
#pragma unroll
    for (int j = 0; j < 8; ++j) g[j] = gk ? gk[k0 + 8 * c + j] : 1.f;
#pragma unroll
    for (int jj = 0; jj < 8; ++jj) { const int n = (lane & 3) + 4 * jj; const LAS float* s = scr + (8 * c) * 33 + n; const float sc = sn ? sn[n0 + n] : 1.f;
        u32x4 o; o.x = cvt_pk_bf16(s[0 * 33] * g[0] * sc, s[1 * 33] * g[1] * sc); o.y = cvt_pk_bf16(s[2 * 33] * g[2] * sc, s[3 * 33] * g[3] * sc);
        o.z = cvt_pk_bf16(s[4 * 33] * g[4] * sc, s[5 * 33] * g[5] * sc); o.w = cvt_pk_bf16(s[6 * 33] * g[6] * sc, s[7 * 33] * g[7] * sc);
        *(u32x4*)(WT + (size_t)(n0 + n) * ldt + k0 + 8 * c) = o; }
    LDS_WAIT(); asm volatile("" ::: "memory");
}
__device__ __forceinline__ void p0_transpose_item128_f8(const float* W, int N, unsigned char* WT, int ldt, float scl, LAS float* scr, int item, int lane) {
    const int nblk = N / 32, kb = item / nblk, nb = item % nblk, k0 = 128 * kb, n0 = 32 * nb;
    p0_tile128_load(W, N, k0, n0, scr, lane);
    const int c = lane >> 3;
#pragma unroll
    for (int jj = 0; jj < 4; ++jj) { const int n = (lane & 7) + 8 * jj; const LAS float* sp = scr + (16 * c) * 33 + n; u32x4 o;
#pragma unroll
        for (int q = 0; q < 4; ++q) { int pk = 0; pk = __builtin_amdgcn_cvt_pk_fp8_f32(sp[(4 * q) * 33] * scl, sp[(4 * q + 1) * 33] * scl, pk, false); pk = __builtin_amdgcn_cvt_pk_fp8_f32(sp[(4 * q + 2) * 33] * scl, sp[(4 * q + 3) * 33] * scl, pk, true); o[q] = (unsigned)pk; }
        *(u32x4*)(WT + (size_t)(n0 + n) * ldt + k0 + 16 * c) = o; }
    LDS_WAIT(); asm volatile("" ::: "memory");
}
__device__ __forceinline__ void rms_row_to_fp8(const float* xrow, const float* gain, unsigned char* orow, int lane) {
    f32x4 v[4][4]; float sq = 0.f;
#pragma unroll
    for (int i = 0; i < 4; ++i)
#pragma unroll
        for (int k = 0; k < 4; ++k) { v[i][k] = *(const f32x4*)(xrow + i * 1024 + lane * 16 + k * 4); sq += (v[i][k].x * v[i][k].x + v[i][k].y * v[i][k].y) + (v[i][k].z * v[i][k].z + v[i][k].w * v[i][k].w); }
    const float rs = __builtin_amdgcn_rsqf(wave_sum(sq) * (1.0f / DM) + EPS);
#pragma unroll
    for (int i = 0; i < 4; ++i) { u32x4 w;
#pragma unroll
        for (int k = 0; k < 4; ++k) { const f32x4 g = *(const f32x4*)(gain + i * 1024 + lane * 16 + k * 4); int p = 0;
            p = __builtin_amdgcn_cvt_pk_fp8_f32(v[i][k].x * rs * g.x, v[i][k].y * rs * g.y, p, false); p = __builtin_amdgcn_cvt_pk_fp8_f32(v[i][k].z * rs * g.z, v[i][k].w * rs * g.w, p, true); w[k] = (unsigned)p; }
        *(u32x4*)(orow + i * 1024 + lane * 16) = w; }
}
__device__ __forceinline__ void rms_row_to_bf16(const float* xrow, const float* gain, bf16* orow, int lane) {
    const f32x4* xr = (const f32x4*)xrow + lane; f32x4 v[16]; float s = 0.f;
#pragma unroll
    for (int j = 0; j < 16; ++j) { v[j] = xr[64 * j]; s += (v[j].x * v[j].x + v[j].y * v[j].y) + (v[j].z * v[j].z + v[j].w * v[j].w); }
    const float rs = __builtin_amdgcn_rsqf(wave_sum(s) * (1.0f / DM) + EPS);
    u32x2* o8 = (u32x2*)orow + lane; const f32x4* gr = (const f32x4*)gain + lane;
#pragma unroll
    for (int j = 0; j < 16; ++j) { const f32x4 gg = gr[64 * j]; u32x2 w; w.x = cvt_pk_bf16(v[j].x * rs * gg.x, v[j].y * rs * gg.y); w.y = cvt_pk_bf16(v[j].z * rs * gg.z, v[j].w * rs * gg.w); o8[64 * j] = w; }
}
__device__ __forceinline__ void p0_quant_load(const float* src, f32x4 (&v)[4][4], int lane) {
#pragma unroll
    for (int i = 0; i < 4; ++i)
#pragma unroll
        for (int k = 0; k < 4; ++k) v[i][k] = *(const f32x4*)(src + i * 1024 + lane * 16 + k * 4);
}
__device__ __forceinline__ void p0_quant_store(const f32x4 (&v)[4][4], unsigned char* dst4, unsigned char* dst6, float* amax_out, int lane, unsigned char* dst2 = nullptr, float* s2_out = nullptr, unsigned char* dst1 = nullptr, float* s1_out = nullptr) {
    float am = 0.f;
#pragma unroll
    for (int i = 0; i < 4; ++i)
#pragma unroll
        for (int k = 0; k < 4; ++k) am = __builtin_fmaxf(am, __builtin_fmaxf(__builtin_fmaxf(__builtin_fabsf(v[i][k].x), __builtin_fabsf(v[i][k].y)), __builtin_fmaxf(__builtin_fabsf(v[i][k].z), __builtin_fabsf(v[i][k].w))));
    am = wave_max_x(am, lane);
    if (lane == 0) *amax_out = am;
    { const float inv = am > 0.f ? 7.5f / am : 0.f; u32x6 g[2];
#pragma unroll
      for (int h = 0; h < 2; ++h) { f32x16 a, b;
#pragma unroll
          for (int e = 0; e < 16; ++e) { const int i = 2 * h + (e >> 3), t0 = 2 * (e & 7), t1 = t0 + 1;
              a[e] = v[i][t0 >> 2][t0 & 3] * inv; b[e] = v[i][t1 >> 2][t1 & 3] * inv; }
          g[h] = __builtin_amdgcn_cvt_scalef32_2xpk16_fp6_f32(a, b, 1.0f); }
      *(u32x4*)(dst6 + lane * 16) = (u32x4){g[0][0], g[0][1], g[0][2], g[0][3]};
      *(u32x4*)(dst6 + 1024 + lane * 16) = (u32x4){g[0][4], g[0][5], g[1][0], g[1][1]};
      *(u32x4*)(dst6 + 2048 + lane * 16) = (u32x4){g[1][2], g[1][3], g[1][4], g[1][5]}; }
    { const float inv = am > 0.f ? 6.0f / am : 0.f;
#pragma unroll
      for (int c = 0; c < 2; ++c) { u32x4 w;
#pragma unroll
          for (int d = 0; d < 4; ++d) { unsigned pk = 0;
              const f32x4 q0 = v[2 * c + (d >> 1)][2 * (d & 1)] * inv, q1 = v[2 * c + (d >> 1)][2 * (d & 1) + 1] * inv;
              pk = __builtin_amdgcn_cvt_scalef32_pk_fp4_f32(pk, q0.x, q0.y, 1.0f, 0); pk = __builtin_amdgcn_cvt_scalef32_pk_fp4_f32(pk, q0.z, q0.w, 1.0f, 1);
              pk = __builtin_amdgcn_cvt_scalef32_pk_fp4_f32(pk, q1.x, q1.y, 1.0f, 2); pk = __builtin_amdgcn_cvt_scalef32_pk_fp4_f32(pk, q1.z, q1.w, 1.0f, 3); w[d] = pk; }
          *(u32x4*)(dst4 + 1024 * c + lane * 16) = w; } }
    if (dst2) {
        float sq = 0.f;
#pragma unroll
        for (int i = 0; i < 4; ++i)
#pragma unroll
            for (int k = 0; k < 4; ++k) sq += (v[i][k].x * v[i][k].x + v[i][k].y * v[i][k].y) + (v[i][k].z * v[i][k].z + v[i][k].w * v[i][k].w);
        sq = wave_sum_x(sq, lane);
        const float s2 = 0.98f * __builtin_sqrtf(sq * (1.0f / DM)); if (lane == 0) *s2_out = s2;
        u32x4 q;
#pragma unroll
        for (int D = 0; D < 4; ++D) { unsigned im[2];
#pragma unroll
            for (int h = 0; h < 2; ++h) { unsigned pk = 0; f32x4 q0 = v[D][2 * h], q1 = v[D][2 * h + 1];
#pragma unroll
                for (int c = 0; c < 4; ++c) { q0[c] = __builtin_copysignf(__builtin_fabsf(q0[c]) > s2 ? 1.5f : 0.5f, q0[c]); q1[c] = __builtin_copysignf(__builtin_fabsf(q1[c]) > s2 ? 1.5f : 0.5f, q1[c]); }
                pk = __builtin_amdgcn_cvt_scalef32_pk_fp4_f32(pk, q0.x, q0.y, 1.0f, 0); pk = __builtin_amdgcn_cvt_scalef32_pk_fp4_f32(pk, q0.z, q0.w, 1.0f, 1);
                pk = __builtin_amdgcn_cvt_scalef32_pk_fp4_f32(pk, q1.x, q1.y, 1.0f, 2); pk = __builtin_amdgcn_cvt_scalef32_pk_fp4_f32(pk, q1.z, q1.w, 1.0f, 3); im[h] = pk; }
            q[D] = ((im[0] >> 2) & 0x22222222u) | ((im[0] >> 1) & 0x11111111u) | (im[1] & 0x88888888u) | ((im[1] << 1) & 0x44444444u); }
        *(u32x4*)(dst2 + lane * 16) = q; }
    if (dst1) {
        float sa = 0.f;
#pragma unroll
        for (int i = 0; i < 4; ++i)
#pragma unroll
            for (int k = 0; k < 4; ++k) sa += (__builtin_fabsf(v[i][k].x) + __builtin_fabsf(v[i][k].y)) + (__builtin_fabsf(v[i][k].z) + __builtin_fabsf(v[i][k].w));
        sa = wave_sum_x(sa, lane);
        if (lane == 0) *s1_out = sa * (1.0f / DM);
        unsigned b[2] = {0u, 0u};
#pragma unroll
        for (int D = 0; D < 4; ++D)
#pragma unroll
            for (int h = 0; h < 2; ++h) { unsigned pk = 0; const f32x4 q0 = v[D][2 * h], q1 = v[D][2 * h + 1];
                pk = __builtin_amdgcn_cvt_scalef32_pk_fp4_f32(pk, __builtin_copysignf(1.0f, q0.x), __builtin_copysignf(1.0f, q0.y), 1.0f, 0); pk = __builtin_amdgcn_cvt_scalef32_pk_fp4_f32(pk, __builtin_copysignf(1.0f, q0.z), __builtin_copysignf(1.0f, q0.w), 1.0f, 1);
                pk = __builtin_amdgcn_cvt_scalef32_pk_fp4_f32(pk, __builtin_copysignf(1.0f, q1.x), __builtin_copysignf(1.0f, q1.y), 1.0f, 2); pk = __builtin_amdgcn_cvt_scalef32_pk_fp4_f32(pk, __builtin_copysignf(1.0f, q1.z), __builtin_copysignf(1.0f, q1.w), 1.0f, 3);
                unsigned x = (pk >> 3) & 0x11111111u; x = (x | (x >> 3)) & 0x03030303u; x = (x | (x >> 6)) & 0x000F000Fu; x = (x | (x >> 12)) & 0xFFu;
                const int B = 2 * D + h; b[B >> 2] |= x << (8 * (B & 3)); }
        *(u32x2*)(dst1 + lane * 8) = (u32x2){b[0], b[1]}; }
}
__device__ __forceinline__ void p0_convert(const float* src, bf16* dst, size_t n, size_t gtid, size_t nthr) {
    const size_t nch = n / 8;
    for (size_t i = gtid; i < nch; i += 4 * nthr) {
        f32x4 a[4][2];
#pragma unroll
        for (int u = 0; u < 4; ++u) { const size_t c = i + u * nthr; if (c < nch) { a[u][0] = *(const f32x4*)(src + c * 8); a[u][1] = *(const f32x4*)(src + c * 8 + 4); } }
#pragma unroll
        for (int u = 0; u < 4; ++u) { const size_t c = i + u * nthr; if (c < nch) *(u32x4*)(dst + c * 8) = pg8::pack8(a[u][0], a[u][1]); }
    }
}

typedef float f32x16v __attribute__((ext_vector_type(16)));
__device__ __forceinline__ f32x16 mfma32(const bf16x8 a, const bf16x8 b, const f32x16 c) { return __builtin_amdgcn_mfma_f32_32x32x16_bf16(a, b, c, 0, 0, 0); }
__device__ __forceinline__ f32x16 zero16() { f32x16 z;
#pragma unroll
    for (int i = 0; i < 16; ++i) { float e; asm volatile("v_mov_b32 %0, 0" : "=v"(e)); z[i] = e; }
    return z; }
__device__ __forceinline__ void mfma_done(const f32x16& a) { const float d = a[0] + a[15]; asm volatile("s_nop 7" :: "v"(d) : "memory"); }
__device__ __forceinline__ void mfma_done4(const f32x16& a, const f32x16& b, const f32x16& c, const f32x16& e) { const float d = (a[0] + b[0]) + (c[0] + e[0]); asm volatile("s_nop 7" :: "v"(d) : "memory"); }
constexpr float SB_EXIT = 30.0f;
constexpr float ATTN_SC = 8.0f, MIXED_SC = 16.0f, WBR_SC = 64.0f, GATED_SC = 16.0f;
__device__ __forceinline__ void sb_attn_item(const bf16* qb, const bf16* kb, const bf16* vT, bf16* attn, int h, int qt, int lane) {
    const int r = lane & 31, hh = lane >> 5, t0 = qt * 32;
    const float scale = 0.08838834764831845f;
    const bf16* qbase_p = qb + (size_t)t0 * SBW + h * HD;
    const unsigned voffKQ = (unsigned)(r * SBW + 8 * hh) * 2u, voffV = (unsigned)(r * SEQ + 4 * hh) * 2u;
    f32x16 o[4];
#pragma unroll
    for (int nb = 0; nb < 4; ++nb) o[nb] = zero16();
    float carry = 0.f;
    for (int jb = 0; ; ++jb) {
        const int kbase = t0 - 32 * jb; if (kbase < 0) break;
        bf16x8 kf[8], qf[8]; u32x4 vf0[4], vf1[4];
        const bf16* kbase_p = kb + (size_t)kbase * SBW + h * HD;
#pragma unroll
        for (int st = 0; st < 8; ++st) { kf[st] = __builtin_bit_cast(bf16x8, ld16(kbase_p, voffKQ, 32 * st)); qf[st] = __builtin_bit_cast(bf16x8, ld16(qbase_p, voffKQ, 32 * st)); }
#pragma unroll
        for (int nb = 0; nb < 4; ++nb) { const bf16* vb = vT + (size_t)(h * HD + nb * 32) * SEQ + kbase;
            const u32x2 lo = ld8(vb, voffV, 0), hi = ld8(vb, voffV, 16); vf0[nb].x = lo.x; vf0[nb].y = lo.y; vf0[nb].z = hi.x; vf0[nb].w = hi.y; }
        asm volatile("s_waitcnt vmcnt(0)\n\ts_nop 7" ::: "memory");
        f32x16 s = zero16();
#pragma unroll
        for (int st = 0; st < 8; ++st) s = mfma32(kf[st], qf[st], s);
        mfma_done(s);
#pragma unroll
        for (int nb = 0; nb < 4; ++nb) { const bf16* vb = vT + (size_t)(h * HD + nb * 32) * SEQ + kbase;
            const u32x2 lo = ld8(vb, voffV, 32), hi = ld8(vb, voffV, 48); vf1[nb].x = lo.x; vf1[nb].y = lo.y; vf1[nb].z = hi.x; vf1[nb].w = hi.y; }
        float z[16], sp[16];
#pragma unroll
        for (int i = 0; i < 16; ++i) { z[i] = s[i] * scale; const int koff = 8 * (i >> 2) + 4 * hh + (i & 3);
            const bool valid = (jb > 0) || (koff < r);
            const float az = __builtin_fabsf(z[i]);
            const float v = __builtin_fmaxf(z[i], 0.f) + LN2 * flog2(1.0f + fexp2(-az * LOG2E));
            sp[i] = valid ? v : 0.f; }
        float G[4], P[4];
#pragma unroll
        for (int g = 0; g < 4; ++g) { G[g] = (sp[4 * g] + sp[4 * g + 1]) + (sp[4 * g + 2] + sp[4 * g + 3]); P[g] = xchg32(G[g], hh); }
        float after = carry;
        unsigned pk[8];
#pragma unroll
        for (int g = 3; g >= 0; --g) {
            const float base = after + (hh == 0 ? P[g] : 0.f);
            float c3 = base + sp[4 * g + 3], c2 = c3 + sp[4 * g + 2], c1 = c2 + sp[4 * g + 1], c0 = c1 + sp[4 * g];
            float a0 = fexp2((z[4 * g] - c0) * LOG2E), a1 = fexp2((z[4 * g + 1] - c1) * LOG2E), a2 = fexp2((z[4 * g + 2] - c2) * LOG2E), a3 = fexp2((z[4 * g + 3] - c3) * LOG2E);
            if (jb == 0) { const int k0 = 8 * g + 4 * hh; a0 = (k0 < r) ? a0 : 0.f; a1 = (k0 + 1 < r) ? a1 : 0.f; a2 = (k0 + 2 < r) ? a2 : 0.f; a3 = (k0 + 3 < r) ? a3 : 0.f; }
            pk[2 * g] = cvt_pk_bf16(a0, a1); pk[2 * g + 1] = cvt_pk_bf16(a2, a3);
            after += G[g] + P[g];
        }
        carry = after;
        asm volatile("s_waitcnt vmcnt(0)\n\ts_nop 7" ::: "memory");
        { bf16x8 pf; { u32x4 w; w.x = pk[0]; w.y = pk[1]; w.z = pk[2]; w.w = pk[3]; pf = __builtin_bit_cast(bf16x8, w); }
#pragma unroll
          for (int nb = 0; nb < 4; ++nb) o[nb] = mfma32(__builtin_bit_cast(bf16x8, vf0[nb]), pf, o[nb]); }
        { bf16x8 pf; { u32x4 w; w.x = pk[4]; w.y = pk[5]; w.z = pk[6]; w.w = pk[7]; pf = __builtin_bit_cast(bf16x8, w); }
#pragma unroll
          for (int nb = 0; nb < 4; ++nb) o[nb] = mfma32(__builtin_bit_cast(bf16x8, vf1[nb]), pf, o[nb]); }
        mfma_done4(o[0], o[1], o[2], o[3]);
        if (__all(carry > SB_EXIT)) break;
    }
    bf16* orow = attn + (size_t)(t0 + r) * SBW + h * HD + 4 * hh;
#pragma unroll
    for (int nb = 0; nb < 4; ++nb)
#pragma unroll
        for (int g = 0; g < 4; ++g) { u32x2 w; w.x = cvt_pk_bf16(o[nb][4 * g], o[nb][4 * g + 1]); w.y = cvt_pk_bf16(o[nb][4 * g + 2], o[nb][4 * g + 3]);
            *(u32x2*)(orow + nb * 32 + 8 * g) = w; }
}

constexpr int XK_STRIDE = 272, XV_STRIDE = 520, XV_OFF = MEML * XK_STRIDE;
__device__ __forceinline__ void xattn_item(const float* xqs, const float* ss2, LAS const unsigned char* ldsK, LAS const unsigned char* ldsV, bf16* ob, int h, int tt, int lane) {
    const int r = lane & 31, hh = lane >> 5, t0 = tt * 32, tok = t0 + r;
    const float qs = __builtin_amdgcn_rsqf(ss2[tok] * (1.0f / DM) + EPS) * 0.08838834764831845f;
    bf16x8 qf[8];
#pragma unroll
    for (int s = 0; s < 8; ++s) { f32x4 a0 = (f32x4){0.f, 0.f, 0.f, 0.f}, a1 = a0;
#pragma unroll
        for (int ks = 0; ks < 4; ++ks) { const float* p = xqs + (size_t)ks * SEQ * XAW + (size_t)tok * XAW + h * HD + 16 * s + 8 * hh; a0 = a0 + *(const f32x4*)p; a1 = a1 + *(const f32x4*)(p + 4); }
        qf[s] = __builtin_bit_cast(bf16x8, pg8::pack8(a0 * qs, a1 * qs)); }
    float mx = -3.0e38f;
#pragma unroll 1
    for (int kbk = 0; kbk < 8; ++kbk) {
        f32x16 sc = zero16();
        LAS const unsigned char* krow = ldsK + (kbk * 32 + r) * XK_STRIDE + 16 * hh;
#pragma unroll
        for (int hf = 0; hf < 2; ++hf) {
            bf16x8 kf[4];
#pragma unroll
            for (int st = 0; st < 4; ++st) kf[st] = *(LAS const bf16x8*)(krow + 32 * (4 * hf + st));
            asm volatile("s_waitcnt lgkmcnt(0)\n\ts_nop 3" ::: "memory");
#pragma unroll
            for (int st = 0; st < 4; ++st) sc = mfma32(kf[st], qf[4 * hf + st], sc);
            mfma_done(sc); }
#pragma unroll
        for (int i = 0; i < 16; ++i) mx = __builtin_fmaxf(mx, sc[i]);
    }
    mx = __builtin_fmaxf(mx, xchg32(mx, hh));
    float sum = 0.f;
    f32x16 o[4];
#pragma unroll
    for (int nb = 0; nb < 4; ++nb) o[nb] = zero16();
#pragma unroll 1
    for (int kbk = 0; kbk < 8; ++kbk) {
        f32x16 sc = zero16();
        LAS const unsigned char* krow = ldsK + (kbk * 32 + r) * XK_STRIDE + 16 * hh;
#pragma unroll
        for (int hf = 0; hf < 2; ++hf) {
            bf16x8 kf[4];
#pragma unroll
            for (int st = 0; st < 4; ++st) kf[st] = *(LAS const bf16x8*)(krow + 32 * (4 * hf + st));
            asm volatile("s_waitcnt lgkmcnt(0)\n\ts_nop 3" ::: "memory");
#pragma unroll
            for (int st = 0; st < 4; ++st) sc = mfma32(kf[st], qf[4 * hf + st], sc);
            mfma_done(sc); }
        unsigned pk[8];
#pragma unroll
        for (int i = 0; i < 16; i += 2) { const float e0 = fexp2((sc[i] - mx) * LOG2E), e1 = fexp2((sc[i + 1] - mx) * LOG2E); sum += e0 + e1; pk[i >> 1] = cvt_pk_bf16(e0, e1); }
#pragma unroll
        for (int s2 = 0; s2 < 2; ++s2) {
            bf16x8 pf; { u32x4 w; w.x = pk[4 * s2]; w.y = pk[4 * s2 + 1]; w.z = pk[4 * s2 + 2]; w.w = pk[4 * s2 + 3]; pf = __builtin_bit_cast(bf16x8, w); }
            u32x4 vf[4];
#pragma unroll
            for (int nb = 0; nb < 4; ++nb) {
                LAS const unsigned char* vrow = ldsV + (nb * 32 + r) * XV_STRIDE + (kbk * 32 + 16 * s2 + 4 * hh) * 2;
                const u32x2 lo = *(LAS const u32x2*)vrow, hi = *(LAS const u32x2*)(vrow + 16);
                vf[nb].x = lo.x; vf[nb].y = lo.y; vf[nb].z = hi.x; vf[nb].w = hi.y; }
            asm volatile("s_waitcnt lgkmcnt(0)\n\ts_nop 3" ::: "memory");
#pragma unroll
            for (int nb = 0; nb < 4; ++nb) o[nb] = mfma32(__builtin_bit_cast(bf16x8, vf[nb]), pf, o[nb]);
            mfma_done4(o[0], o[1], o[2], o[3]);
        }
    }
    sum += xchg32(sum, hh);
    const float inv = frcp(sum);
    bf16* orow = ob + (size_t)tok * XAW + h * HD + 4 * hh;
#pragma unroll
    for (int nb = 0; nb < 4; ++nb)
#pragma unroll
        for (int g = 0; g < 4; ++g) { u32x2 w; w.x = cvt_pk_bf16(o[nb][4 * g] * inv, o[nb][4 * g + 1] * inv); w.y = cvt_pk_bf16(o[nb][4 * g + 2] * inv, o[nb][4 * g + 3] * inv); *(u32x2*)(orow + nb * 32 + 8 * g) = w; }
}

template <int N> __device__ __forceinline__ void bitonic_sort_desc(float (&a)[N]) {
#pragma unroll
    for (int k = 2; k <= N; k <<= 1)
#pragma unroll
        for (int j = k >> 1; j > 0; j >>= 1)
#pragma unroll
            for (int i = 0; i < N; ++i) { const int l = i ^ j; if (l > i) { const bool desc = ((i & k) == 0); const float lo = __builtin_fminf(a[i], a[l]), hi = __builtin_fmaxf(a[i], a[l]); a[i] = desc ? hi : lo; a[l] = desc ? lo : hi; } }
}
__device__ __forceinline__ void merge_top16(float (&a)[16], const float (&b)[16]) {
#pragma unroll
    for (int i = 0; i < 16; ++i) a[i] = __builtin_fmaxf(a[i], b[15 - i]);
#pragma unroll
    for (int j = 8; j > 0; j >>= 1)
#pragma unroll
        for (int i = 0; i < 16; ++i) { const int l = i ^ j; if (l > i) { const float lo = __builtin_fminf(a[i], a[l]), hi = __builtin_fmaxf(a[i], a[l]); a[i] = hi; a[l] = lo; } }
}
__device__ __forceinline__ void top16_of_64(const float (&v)[64], float (&out)[16]) {
    float g0[16], g1[16], g2[16], g3[16];
#pragma unroll
    for (int i = 0; i < 16; ++i) { g0[i] = v[i]; g1[i] = v[16 + i]; g2[i] = v[32 + i]; g3[i] = v[48 + i]; }
    bitonic_sort_desc<16>(g0); bitonic_sort_desc<16>(g1); bitonic_sort_desc<16>(g2); bitonic_sort_desc<16>(g3);
    merge_top16(g0, g1); merge_top16(g2, g3); merge_top16(g0, g2);
#pragma unroll
    for (int i = 0; i < 16; ++i) out[i] = g0[i];
}
__device__ __forceinline__ float pack_tag(float v, unsigned tag, unsigned mask) { return __builtin_bit_cast(float, (__builtin_bit_cast(unsigned, v) & ~mask) | tag); }
__device__ __forceinline__ void route_item(const bf16* pq, const bf16* keys, int* eid, float* gate, int h, int tt, int lane) {
    const int r = lane & 31, hh = lane >> 5, tok = tt * 32 + r;
    float top[2][16];
#pragma unroll
    for (int p = 0; p < 2; ++p) {
        bf16x8 qf[8];
        { const bf16* qrow = pq + (size_t)tok * PQW + h * 256 + p * 128 + 8 * hh;
#pragma unroll
          for (int s = 0; s < 8; ++s) qf[s] = *(const bf16x8*)(qrow + 16 * s); }
        asm volatile("s_waitcnt vmcnt(0)" ::: "memory");
        float mine[16], other[16];
#pragma unroll
        for (int kbk = 0; kbk < 4; ++kbk) {
            f32x16 sc = zero16();
            const bf16* krow = keys + (size_t)((h * 2 + p) * PKEYS + kbk * 32 + r) * 128 + 8 * hh;
#pragma unroll
            for (int hf = 0; hf < 2; ++hf) {
                bf16x8 kf[4];
#pragma unroll
                for (int st = 0; st < 4; ++st) kf[st] = *(const bf16x8*)(krow + 16 * (4 * hf + st));
                asm volatile("s_waitcnt vmcnt(0)\n\ts_nop 7" ::: "memory");
#pragma unroll
                for (int st = 0; st < 4; ++st) sc = mfma32(kf[st], qf[4 * hf + st], sc);
                mfma_done(sc); }
            float blk[16];
#pragma unroll
            for (int i = 0; i < 16; ++i) { const unsigned key = (unsigned)(kbk * 32 + 8 * (i >> 2) + (i & 3)) + 4u * (unsigned)hh; blk[i] = pack_tag(sc[i], key, 127u); }
            bitonic_sort_desc<16>(blk);
            if (kbk == 0) {
#pragma unroll
                for (int i = 0; i < 16; ++i) mine[i] = blk[i];
            } else merge_top16(mine, blk);
        }
#pragma unroll
        for (int i = 0; i < 16; ++i) other[i] = xchg32(mine[i], hh);
        merge_top16(mine, other);
#pragma unroll
        for (int i = 0; i < 16; ++i) top[p][i] = mine[i];
    }
    float best[16];
    {
        float cv[64]; int nc = 0;
#pragma unroll
        for (int i = 0; i < 16; ++i)
#pragma unroll
            for (int j = 0; j < 16; ++j) if ((i + 1) * (j + 1) <= 16) { cv[nc] = pack_tag(top[0][i] + top[1][j], (unsigned)(i * 16 + j), 255u); ++nc; }
#pragma unroll
        for (int i = 50; i < 64; ++i) cv[i] = -3.0e38f;
#pragma unroll
        for (int gq = 0; gq < 4; ++gq) { float blk[16];
#pragma unroll
            for (int i = 0; i < 16; ++i) blk[i] = cv[gq * 16 + i];
            bitonic_sort_desc<16>(blk);
            if (gq == 0) {
#pragma unroll
                for (int i = 0; i < 16; ++i) best[i] = blk[i];
            } else merge_top16(best, blk); }
    }
    const float mx = best[0];
    float den = 0.f;
#pragma unroll
    for (int i = 0; i < 16; ++i) den += fexp2((best[i] - mx) * LOG2E);
    const float inv = frcp(den);
    if (hh == 0) {
        int* eo = eid + (size_t)tok * 128 + h * 16; float* go = gate + (size_t)tok * 128 + h * 16;
#pragma unroll
        for (int k = 0; k < 16; ++k) {
            const unsigned tag = __builtin_bit_cast(unsigned, best[k]) & 255u; const int i = (int)(tag >> 4), j = (int)(tag & 15u);
            unsigned k1 = 0u, k2 = 0u;
#pragma unroll
            for (int q = 0; q < 16; ++q) { k1 = (i == q) ? (__builtin_bit_cast(unsigned, top[0][q]) & 127u) : k1; k2 = (j == q) ? (__builtin_bit_cast(unsigned, top[1][q]) & 127u) : k2; }
            eo[k] = (int)(k1 * 128u + k2); go[k] = fexp2((best[k] - mx) * LOG2E) * inv;
        }
    }
}

__device__ __forceinline__ float gelu_erf(float u) { return 0.5f * u * (1.0f + erff(u * 0.70710678118654752f)); }
struct Row6 { u32x4 p0, p1, p2; };
__device__ __forceinline__ f32x32 unpack6(const Row6& r, int h) { const u32x6 g = h ? (u32x6){r.p1.z, r.p1.w, r.p2.x, r.p2.y, r.p2.z, r.p2.w} : (u32x6){r.p0.x, r.p0.y, r.p0.z, r.p0.w, r.p1.x, r.p1.y};
    return __builtin_amdgcn_cvt_scalef32_pk32_f32_fp6(g, 1.0f); }
__device__ __forceinline__ float dot_row4(const Row6& r, const f32x4 (&x)[4][4]) {
    f32x2 d = (f32x2){0.f, 0.f};
#pragma unroll
    for (int c = 0; c < 2; ++c) { const u32x4 w = c ? r.p1 : r.p0;
#pragma unroll
        for (int dw = 0; dw < 4; ++dw) { const f32x4 x0 = x[2 * c + (dw >> 1)][2 * (dw & 1)], x1 = x[2 * c + (dw >> 1)][2 * (dw & 1) + 1];
            d = __builtin_elementwise_fma(__builtin_amdgcn_cvt_scalef32_pk_f32_fp4(w[dw], 1.0f, 0), (f32x2){x0.x, x0.y}, d); d = __builtin_elementwise_fma(__builtin_amdgcn_cvt_scalef32_pk_f32_fp4(w[dw], 1.0f, 1), (f32x2){x0.z, x0.w}, d);
            d = __builtin_elementwise_fma(__builtin_amdgcn_cvt_scalef32_pk_f32_fp4(w[dw], 1.0f, 2), (f32x2){x1.x, x1.y}, d); d = __builtin_elementwise_fma(__builtin_amdgcn_cvt_scalef32_pk_f32_fp4(w[dw], 1.0f, 3), (f32x2){x1.z, x1.w}, d); }
        __builtin_amdgcn_sched_barrier(0); }
    return d.x + d.y;
}
__device__ __forceinline__ void axpy_row4(const Row6& r, const float a, f32x2 (&acc)[4][8]) {
    const f32x2 a2 = (f32x2){a, a};
#pragma unroll
    for (int c = 0; c < 2; ++c) { const u32x4 w = c ? r.p1 : r.p0;
#pragma unroll
        for (int dw = 0; dw < 4; ++dw) { const int ci = 2 * c + (dw >> 1), kb = 4 * (dw & 1);
            acc[ci][kb]     = __builtin_elementwise_fma(__builtin_amdgcn_cvt_scalef32_pk_f32_fp4(w[dw], 1.0f, 0), a2, acc[ci][kb]);
            acc[ci][kb + 1] = __builtin_elementwise_fma(__builtin_amdgcn_cvt_scalef32_pk_f32_fp4(w[dw], 1.0f, 1), a2, acc[ci][kb + 1]);
            acc[ci][kb + 2] = __builtin_elementwise_fma(__builtin_amdgcn_cvt_scalef32_pk_f32_fp4(w[dw], 1.0f, 2), a2, acc[ci][kb + 2]);
            acc[ci][kb + 3] = __builtin_elementwise_fma(__builtin_amdgcn_cvt_scalef32_pk_f32_fp4(w[dw], 1.0f, 3), a2, acc[ci][kb + 3]); }
        __builtin_amdgcn_sched_barrier(0); }
}
#define W6(c_, e_) (16 * (c_) + (e_))
__device__ __forceinline__ float dot_row6(const Row6& r, const f32x4 (&x)[4][4]) {
    f32x2 d = (f32x2){0.f, 0.f};
#pragma unroll
    for (int h = 0; h < 2; ++h) { const f32x32 w = unpack6(r, h);
#pragma unroll
        for (int c = 0; c < 2; ++c)
#pragma unroll
            for (int k = 0; k < 4; ++k) { d = __builtin_elementwise_fma((f32x2){w[W6(c, 4 * k)], w[W6(c, 4 * k + 1)]}, (f32x2){x[2 * h + c][k].x, x[2 * h + c][k].y}, d);
                                          d = __builtin_elementwise_fma((f32x2){w[W6(c, 4 * k + 2)], w[W6(c, 4 * k + 3)]}, (f32x2){x[2 * h + c][k].z, x[2 * h + c][k].w}, d); }
        __builtin_amdgcn_sched_barrier(0); }
    return d.x + d.y;
}
__device__ __forceinline__ void axpy_row6(const Row6& r, const float a, f32x2 (&acc)[4][8]) {
    const f32x2 a2 = (f32x2){a, a};
#pragma unroll
    for (int h = 0; h < 2; ++h) { const f32x32 w = unpack6(r, h);
#pragma unroll
        for (int c = 0; c < 2; ++c)
#pragma unroll
            for (int k = 0; k < 8; ++k) acc[2 * h + c][k] = __builtin_elementwise_fma((f32x2){w[W6(c, 2 * k)], w[W6(c, 2 * k + 1)]}, a2, acc[2 * h + c][k]);
        __builtin_amdgcn_sched_barrier(0); }
}
__device__ __forceinline__ float reduce4(float d0, float d1, float d2, float d3, int lane) {
    const int hh = lane >> 5, q = (lane >> 4) & 1;
    const float r01 = (hh ? d1 : d0) + xchg32(hh ? d0 : d1, hh);
    const float r23 = (hh ? d3 : d2) + xchg32(hh ? d2 : d3, hh);
    const float r = (q ? r23 : r01) + xchg16(q ? r01 : r23, q);
    return row_sum16(r);
}
__device__ __forceinline__ Row6 expand2(const u32x4 q) { Row6 r;
#pragma unroll
    for (int D = 0; D < 4; ++D) { const unsigned w = q[D];
        const unsigned o0 = ((w & 0x22222222u) << 2) | ((w & 0x11111111u) << 1) | 0x11111111u, o1 = (w & 0x88888888u) | ((w & 0x44444444u) >> 1) | 0x11111111u;
        if (D < 2) { r.p0[2 * (D & 1)] = o0; r.p0[2 * (D & 1) + 1] = o1; } else { r.p1[2 * (D & 1)] = o0; r.p1[2 * (D & 1) + 1] = o1; } }
    r.p2 = (u32x4){0u, 0u, 0u, 0u}; return r; }
__device__ __forceinline__ Row6 expand1(const u32x2 q) { Row6 r;
#pragma unroll
    for (int B = 0; B < 8; ++B) { unsigned x = (q[B >> 2] >> (8 * (B & 3))) & 0xFFu; x = (x | (x << 12)) & 0x000F000Fu; x = (x | (x << 6)) & 0x03030303u; x = (x | (x << 3)) & 0x11111111u;
        const unsigned im = (x << 3) | 0x22222222u; if (B < 4) r.p0[B] = im; else r.p1[B - 4] = im; }
    r.p2 = (u32x4){0u, 0u, 0u, 0u}; return r; }
#define RANK16_STEP(n_) { const float o_ = __builtin_bit_cast(float, __builtin_amdgcn_mov_dpp(__builtin_bit_cast(int, v), 0x120 + (n_), 0xf, 0xf, true)); const int oi_ = __builtin_amdgcn_mov_dpp(me, 0x120 + (n_), 0xf, 0xf, true); cnt += ((o_ > v) || (o_ == v && oi_ < me)) ? 1 : 0; }
__device__ __forceinline__ int rank16(const float v, const int lane) {
    const int me = lane & 15; int cnt = 0;
    RANK16_STEP(1) RANK16_STEP(2) RANK16_STEP(3) RANK16_STEP(4) RANK16_STEP(5) RANK16_STEP(6) RANK16_STEP(7) RANK16_STEP(8) RANK16_STEP(9) RANK16_STEP(10) RANK16_STEP(11) RANK16_STEP(12) RANK16_STEP(13) RANK16_STEP(14) RANK16_STEP(15)
    return cnt;
}
#undef RANK16_STEP
__device__ __forceinline__ void peer_token(const bf16* xrow, float ss, const float* g_ffn, const float* g_fin, const unsigned char* down4, const unsigned char* down6, const unsigned char* up4, const unsigned char* up6, const unsigned char* up2, const unsigned char* up1, const float* sdown, const float* sup, const float* sup2, const float* sup1,
                                           const int* eid, const float* gate, float* orow, int lane) {
    const float rs = __builtin_amdgcn_rsqf(ss * (1.0f / DM) + EPS);
    const unsigned lb = (unsigned)lane * 64u;
    const unsigned l8 = (unsigned)lane * 16u;
    f32x4 xn[4][4];
#pragma unroll
    for (int i = 0; i < 4; ++i)
#pragma unroll
        for (int k = 0; k < 4; k += 2) { const int o = i * 4096 + k * 16; f32x4 x0, x1; pg8::unpack8(ld16(xrow, lb >> 1, o >> 1), x0, x1);
            xn[i][k] = x0 * rs * ld16f(g_ffn, lb, o); xn[i][k + 1] = x1 * rs * ld16f(g_ffn, lb, o + 16); }
    const int e_lo = eid[lane], e_hi = eid[64 + lane];
    float w_lo = 0.f, w_hi = 0.f;
    const float fsc = ((lane & 15) < 2) ? (1.0f / 7.5f) : (1.0f / 6.0f);
    constexpr int PEER_NB = 4;
#define PEER_LD6(buf, tab, jj) do { _Pragma("unroll") for (int q_ = 0; q_ < PEER_NB; ++q_) { const int j_ = (jj) + q_; const int e_ = __builtin_amdgcn_readlane((jj) < 64 ? e_lo : e_hi, j_ & 63); const unsigned vo_ = (unsigned)e_ * (unsigned)ROW6 + l8;     \
        buf[q_].p0 = ld16((tab), vo_, 0); buf[q_].p1 = ld16((tab), vo_, 1024); buf[q_].p2 = ld16((tab), vo_, 2048); } } while (0)
#define PEER_LD4(buf, tab, jj) do { _Pragma("unroll") for (int q_ = 0; q_ < PEER_NB; ++q_) { const int j_ = (jj) + q_; const int e_ = __builtin_amdgcn_readlane((jj) < 64 ? e_lo : e_hi, j_ & 63); const unsigned vo_ = (unsigned)e_ * (unsigned)ROW4 + l8; \
        buf[q_].p0 = ld16((tab), vo_, 0); buf[q_].p1 = ld16((tab), vo_, 1024); } } while (0)
#define PEER_LDM(buf, jj) do { _Pragma("unroll") for (int q_ = 0; q_ < 2; ++q_) { const int j_ = (jj) + q_; const int e_ = __builtin_amdgcn_readlane((jj) < 64 ? e_lo : e_hi, j_ & 63); const unsigned vo_ = (unsigned)e_ * (unsigned)ROW6 + l8;     \
        buf[q_].p0 = ld16(down6, vo_, 0); buf[q_].p1 = ld16(down6, vo_, 1024); buf[q_].p2 = ld16(down6, vo_, 2048); } \
      _Pragma("unroll") for (int q_ = 2; q_ < 4; ++q_) { const int j_ = (jj) + q_; const int e_ = __builtin_amdgcn_readlane((jj) < 64 ? e_lo : e_hi, j_ & 63); const unsigned vo_ = (unsigned)e_ * (unsigned)ROW4 + l8; \
        buf[q_].p0 = ld16(down4, vo_, 0); buf[q_].p1 = ld16(down4, vo_, 1024); } } while (0)
#define PEER_PUT4(r_, jb_) do { const float t0_ = __builtin_bit_cast(float, __builtin_amdgcn_readlane(__builtin_bit_cast(int, r_), 0)), t2_ = __builtin_bit_cast(float, __builtin_amdgcn_readlane(__builtin_bit_cast(int, r_), 16)); \
        const float t1_ = __builtin_bit_cast(float, __builtin_amdgcn_readlane(__builtin_bit_cast(int, r_), 32)), t3_ = __builtin_bit_cast(float, __builtin_amdgcn_readlane(__builtin_bit_cast(int, r_), 48)); \
        const int jl_ = (jb_) & 63; const float tv_ = (lane == jl_) ? t0_ : (lane == jl_ + 1) ? t1_ : (lane == jl_ + 2) ? t2_ : t3_; const bool mine_ = (lane >= jl_) && (lane < jl_ + 4); \
        if ((jb_) < 64) w_lo = mine_ ? tv_ : w_lo; else w_hi = mine_ ? tv_ : w_hi; } while (0)
#define PEER_DOT6(buf, jb_) do { const float r_ = reduce4(dot_row6(buf[0], xn), dot_row6(buf[1], xn), dot_row6(buf[2], xn), dot_row6(buf[3], xn), lane); PEER_PUT4(r_, jb_); } while (0)
#define PEER_DOTM(buf, jb_) do { const float r_ = reduce4(dot_row6(buf[0], xn), dot_row6(buf[1], xn), dot_row4(buf[2], xn), dot_row4(buf[3], xn), lane); PEER_PUT4(r_, jb_); } while (0)
#define PEER_DOT4(buf, jb_) do { const float r_ = reduce4(dot_row4(buf[0], xn), dot_row4(buf[1], xn), dot_row4(buf[2], xn), dot_row4(buf[3], xn), lane); PEER_PUT4(r_, jb_); } while (0)
#define PEER_WQ(jj) __builtin_bit_cast(float, __builtin_amdgcn_readlane(__builtin_bit_cast(int, (jj) < 64 ? w_lo : w_hi), (jj) & 63))
    {
        Row6 bA[PEER_NB], bB[PEER_NB], bC[PEER_NB], bD[PEER_NB];
        PEER_LDM(bA, 0); PEER_LD4(bB, down4, 4);
#pragma unroll 1
        for (int j0 = 0; j0 < 128; j0 += 16) {
            PEER_LD4(bC, down4, j0 + 8);
            PEER_DOTM(bA, j0);
            PEER_LD4(bD, down4, j0 + 12);
            PEER_DOT4(bB, j0 + 4);
            if (j0 + 16 < 128) PEER_LDM(bA, j0 + 16);
            PEER_DOT4(bC, j0 + 8);
            if (j0 + 16 < 128) PEER_LD4(bB, down4, j0 + 20);
            PEER_DOT4(bD, j0 + 12);
        }
    }
    int eu_lo, eu_hi;
    { const float a_lo = gate[lane] * gelu_erf(w_lo * sdown[e_lo] * fsc), a_hi = gate[64 + lane] * gelu_erf(w_hi * sdown[e_hi] * fsc);
      const int d_lo = ((lane & ~15) + rank16(__builtin_fabsf(a_lo), lane)) * 4, d_hi = ((lane & ~15) + rank16(__builtin_fabsf(a_hi), lane)) * 4;
      const float pa_lo = __builtin_bit_cast(float, __builtin_amdgcn_ds_permute(d_lo, __builtin_bit_cast(int, a_lo))), pa_hi = __builtin_bit_cast(float, __builtin_amdgcn_ds_permute(d_hi, __builtin_bit_cast(int, a_hi)));
      eu_lo = __builtin_amdgcn_ds_permute(d_lo, e_lo); eu_hi = __builtin_amdgcn_ds_permute(d_hi, e_hi);
      const int pos = lane & 15; const float fscu = (pos < 2) ? (1.0f / 7.5f) : (1.0f / 6.0f);
      w_lo = pa_lo * ((pos < 8) ? sup[eu_lo] * fscu : (pos < 12) ? sup2[eu_lo] : sup1[eu_lo]); w_hi = pa_hi * ((pos < 8) ? sup[eu_hi] * fscu : (pos < 12) ? sup2[eu_hi] : sup1[eu_hi]); }
    f32x2 acc[4][8];
#pragma unroll
    for (int i = 0; i < 4; ++i)
#pragma unroll
        for (int k = 0; k < 8; ++k) acc[i][k] = (f32x2){0.f, 0.f};
    {
#define PEER_LDU6(buf, jj) do { _Pragma("unroll") for (int q_ = 0; q_ < 2; ++q_) { const int j_ = (jj) + q_; const int e_ = __builtin_amdgcn_readlane((jj) < 64 ? eu_lo : eu_hi, j_ & 63); const unsigned vo_ = (unsigned)e_ * (unsigned)ROW6 + l8; \
        buf[q_].p0 = ld16(up6, vo_, 0); buf[q_].p1 = ld16(up6, vo_, 1024); buf[q_].p2 = ld16(up6, vo_, 2048); } } while (0)
#define PEER_LDU4(buf, jj) do { _Pragma("unroll") for (int q_ = 0; q_ < 2; ++q_) { const int j_ = (jj) + q_; const int e_ = __builtin_amdgcn_readlane((jj) < 64 ? eu_lo : eu_hi, j_ & 63); const unsigned vo_ = (unsigned)e_ * (unsigned)ROW4 + l8; \
        buf[q_].p0 = ld16(up4, vo_, 0); buf[q_].p1 = ld16(up4, vo_, 1024); } } while (0)
#define PEER_LDQ(buf, jj) do { _Pragma("unroll") for (int q_ = 0; q_ < 4; ++q_) { const int j_ = (jj) + q_; const int e_ = __builtin_amdgcn_readlane((jj) < 64 ? eu_lo : eu_hi, j_ & 63); buf[q_] = ld16(up2, (unsigned)e_ * (unsigned)ROW2 + l8, 0); } } while (0)
#define PEER_LD1(buf, jj) do { _Pragma("unroll") for (int q_ = 0; q_ < 4; ++q_) { const int j_ = (jj) + q_; const int e_ = __builtin_amdgcn_readlane((jj) < 64 ? eu_lo : eu_hi, j_ & 63); buf[q_] = ld8(up1, (unsigned)e_ * (unsigned)ROW1 + (l8 >> 1), 0); } } while (0)
        Row6 b0[2], c0[2], c1[2], c2[2]; u32x4 dq[4]; u32x2 d1[4];
        asm volatile("" : "+v"(w_lo), "+v"(w_hi) :: "memory");
        PEER_LDU6(b0, 0); PEER_LDU4(c0, 2);
#pragma unroll 1
        for (int j0 = 0; j0 < 128; j0 += 16) {
            PEER_LDU4(c1, j0 + 4); PEER_LDU4(c2, j0 + 6); PEER_LDQ(dq, j0 + 8); PEER_LD1(d1, j0 + 12);
            axpy_row6(b0[0], PEER_WQ(j0), acc); axpy_row6(b0[1], PEER_WQ(j0 + 1), acc);
            if (j0 + 16 < 128) PEER_LDU6(b0, j0 + 16);
            axpy_row4(c0[0], PEER_WQ(j0 + 2), acc); axpy_row4(c0[1], PEER_WQ(j0 + 3), acc);
            if (j0 + 16 < 128) PEER_LDU4(c0, j0 + 18);
            axpy_row4(c1[0], PEER_WQ(j0 + 4), acc); axpy_row4(c1[1], PEER_WQ(j0 + 5), acc);
            axpy_row4(c2[0], PEER_WQ(j0 + 6), acc); axpy_row4(c2[1], PEER_WQ(j0 + 7), acc);
#pragma unroll
            for (int q = 0; q < 4; ++q) axpy_row4(expand2(dq[q]), PEER_WQ(j0 + 8 + q), acc);
#pragma unroll
            for (int q = 0; q < 4; ++q) axpy_row4(expand1(d1[q]), PEER_WQ(j0 + 12 + q), acc);
        }
#undef PEER_LDQ
#undef PEER_LD1
#undef PEER_LDU6
#undef PEER_LDU4
    }
#undef PEER_LD6
#undef PEER_LD4
#undef PEER_PUT4
#undef PEER_DOT6
#undef PEER_DOT4
#undef PEER_DOTM
#undef PEER_LDM
#undef PEER_WQ
    float s = 0.f;
    { unsigned lb2 = lb; asm volatile("" : "+v"(lb2));
#pragma unroll
    for (int i = 0; i < 4; ++i)
#pragma unroll
        for (int k = 0; k < 4; k += 2) { const int o = i * 4096 + k * 16; f32x4 xr[2]; pg8::unpack8(ld16(xrow, lb2 >> 1, o >> 1), xr[0], xr[1]);
#pragma unroll
            for (int kk = 0; kk < 2; ++kk) { const int k2 = k + kk;
            acc[i][2 * k2] = acc[i][2 * k2] + (f32x2){xr[kk].x, xr[kk].y}; acc[i][2 * k2 + 1] = acc[i][2 * k2 + 1] + (f32x2){xr[kk].z, xr[kk].w};
            s += (acc[i][2 * k2].x * acc[i][2 * k2].x + acc[i][2 * k2].y * acc[i][2 * k2].y) + (acc[i][2 * k2 + 1].x * acc[i][2 * k2 + 1].x + acc[i][2 * k2 + 1].y * acc[i][2 * k2 + 1].y); } }
    const float rf = __builtin_amdgcn_rsqf(wave_sum_x(s, lane) * (1.0f / DM) + EPS);
#pragma unroll
    for (int i = 0; i < 4; ++i)
#pragma unroll
        for (int k = 0; k < 4; ++k) { const int o = i * 4096 + k * 16; const f32x4 gf = ld16f(g_fin, lb2, o);
            *(f32x4*)(((char*)orow + lb2) + o) = (f32x4){acc[i][2 * k].x * rf * gf.x, acc[i][2 * k].y * rf * gf.y, acc[i][2 * k + 1].x * rf * gf.z, acc[i][2 * k + 1].y * rf * gf.w}; }
    }
}

template <int W> __device__ __forceinline__ void pool_item(const bf16* ub, bf16* pooled, int t0, int cb, int lane) {
    const unsigned voff = (unsigned)(cb + lane * 8) * 2u;
    f32x4 s0 = (f32x4){0.f, 0.f, 0.f, 0.f}, s1 = s0;
#pragma unroll
    for (int j = 1; j < W; ++j) { const int t = t0 - j; if (t >= 0) { f32x4 a0, a1; pg8::unpack8(ld16(ub + (size_t)t * PLW, voff), a0, a1); s0 = s0 + a0; s1 = s1 + a1; } }
#pragma unroll
    for (int i = 0; i < 16; ++i) { const int t = t0 + i; f32x4 c0, c1; pg8::unpack8(ld16(ub + (size_t)t * PLW, voff), c0, c1);
        s0 = s0 + c0; s1 = s1 + c1;
        const int n = (t + 1) < W ? (t + 1) : W; const float ic = 1.0f / (float)n;
        *(u32x4*)((char*)(pooled + (size_t)t * PLW) + voff) = pg8::pack8(s0 * ic - c0, s1 * ic - c1);
        const int told = t - W + 1; if (told >= 0) { f32x4 a0, a1; pg8::unpack8(ld16(ub + (size_t)told * PLW, voff), a0, a1); s0 = s0 - a0; s1 = s1 - a1; } }
}

__global__ void __launch_bounds__(512, 2) fwd(Params p) {
    extern __shared__ __attribute__((aligned(16))) unsigned char lds_raw[];
    LAS unsigned char* lds = (LAS unsigned char*)lds_raw;
    volatile LAS unsigned* MISC = (volatile LAS unsigned*)(lds + MISC_OFF);
    const int wave = __builtin_amdgcn_readfirstlane((int)threadIdx.x >> 6);
    const int G = gridDim.x, bx = blockIdx.x;
    const int vcu = (G % 8 == 0) ? (bx % 8) * (G / 8) + bx / 8 : bx;
    const int gw = vcu * 8 + wave, NGW = G * 8;
    unsigned char* ws = p.ws;
    unsigned* ctl = (unsigned*)(ws + WS_CTL);
    for (int u = threadIdx.x; u < (LDS_BYTES - LDSCTL_OFF) / 4; u += 512) ((LAS unsigned*)(lds + LDSCTL_OFF))[u] = 0u;
    __syncthreads();
    XcdBarrier bar = xcd_barrier_post(ctl + CW_BAR, MISC + 8, wave);

    unsigned char* Win8 = ws + WS_WIN; unsigned char* h1_8 = ws + WS_H1; bf16* Wsb_t = (bf16*)(ws + WS_WSB); bf16* Wpool_t = (bf16*)(ws + WS_WPOOL); bf16* Wout_t = (bf16*)(ws + WS_WOUT);
    bf16* Wxq_t = (bf16*)(ws + WS_WXQ); bf16* Wkv_t = (bf16*)(ws + WS_WKV); bf16* Wxo_t = (bf16*)(ws + WS_WXO); bf16* Wpq_t = (bf16*)(ws + WS_WPQ);
    bf16* gw_t = (bf16*)(ws + WS_GW); bf16* keys_b = (bf16*)(ws + WS_KEYS); bf16* mem_n = (bf16*)(ws + WS_MEMN);
    bf16* kvk = (bf16*)(ws + WS_KVB); bf16* kvT = (bf16*)(ws + WS_KVB + 512 * 1024);
    unsigned char* down4 = ws + WS_DOWN4; unsigned char* down6 = ws + WS_DOWN6; unsigned char* up4 = ws + WS_UP4; unsigned char* up6 = ws + WS_UP6; float* sdown = (float*)(ws + WS_SDOWN); float* sup = (float*)(ws + WS_SUP); unsigned char* up2 = ws + WS_UP2; float* sup2 = (float*)(ws + WS_SUP2); unsigned char* up1 = ws + WS_UP1; float* sup1 = (float*)(ws + WS_SUP1);
    bf16* attn = (bf16*)(ws + WS_ATTN); bf16* pooled = (bf16*)(ws + WS_POOLED); bf16* xb = (bf16*)(ws + WS_XB);
    bf16* qb = (bf16*)(ws + WS_Q); bf16* kb = (bf16*)(ws + WS_K); bf16* vT = (bf16*)(ws + WS_VT); bf16* ub = (bf16*)(ws + WS_UB); bf16* gsb = (bf16*)(ws + WS_GSB); bf16* gpl = (bf16*)(ws + WS_GPL);
    bf16* mixed = (bf16*)(ws + WS_MIXED); bf16* pqb = (bf16*)(ws + WS_PQ); int* eid = (int*)(ws + WS_EID); float* gate = (float*)(ws + WS_GATE);
    float* xqs = (float*)(ws + WS_XQS); bf16* ob = (bf16*)(ws + WS_O); float* kvs = (float*)(ws + WS_KVS);
    bf16* Tb = (bf16*)(ws + WS_T); bf16* gated = (bf16*)(ws + WS_GATED);
    float* ss2 = (float*)(ws + WS_CTL + CTL_SS2); float* ss3 = (float*)(ws + WS_CTL + CTL_SS3);

    PROBE_BEGIN(0)
    {
        FRESH_IDS();
        LAS float* scr = (LAS float*)(lds + wave * 16896);
        int it = gw;
#define TJOB(W, K_, N_, WT, LDT, GK, SN) { const int n_it = ((K_) / 64) * ((N_) / 64); for (; it < n_it; it += NGW) p0_transpose_item128((W), (N_), (WT), (LDT), (GK), (SN), scr, it, lane); it -= n_it; }
        { const int n_it = (DM / 64) * (INW / 64); for (; it < n_it; it += NGW) p0_transpose_item128_f8(p.w_in, INW, Win8, DM, 64.0f, scr, it, lane); it -= n_it; }
        TJOB(p.w_branch_sb, SBW, DM, Wsb_t, SBW, nullptr, nullptr)
        { const int n_it = (PLW / 64) * (DM / 64); for (; it < n_it; it += NGW) p0_transpose_item128_f8(p.w_branch_pool, DM, (unsigned char*)Wpool_t, PLW, WBR_SC, scr, it, lane); it -= n_it; }
        { const int n_it = (DM / 64) * (DM / 64); for (; it < n_it; it += NGW) p0_transpose_item128_f8(p.w_out, DM, (unsigned char*)Wout_t, DM, WBR_SC, scr, it, lane); it -= n_it; }
        TJOB(p.xa_w_q, DM, XAW, Wxq_t, DM, p.norm_mem_q, nullptr)
        TJOB(p.xa_w_kv, DM, 2 * XAW, Wkv_t, DM, nullptr, nullptr)
        TJOB(p.xa_w_o, XAW, DM, Wxo_t, XAW, nullptr, nullptr)
        TJOB(p.peer_w_query, DM, PQW, Wpq_t, DM, p.norm_ffn, nullptr)
#pragma unroll 1
        for (int g = 0; g < 4; ++g) TJOB(p.pool_group_w + (size_t)g * 512 * 512, 512, 512, gw_t + (size_t)g * 512 * 512, 512, nullptr, p.pool_scale + g * 512)
#undef TJOB
        for (int m = gw; m < SEQ; m += NGW) rms_row_to_fp8(p.x + (size_t)m * DM, p.norm_mix, h1_8 + (size_t)m * DM, lane);
        for (int m = gw; m < MEML; m += NGW) rms_row_to_bf16(p.mem + (size_t)m * DM, p.norm_mem_kv, mem_n + (size_t)m * DM, lane);
        const size_t gtid = (size_t)vcu * 512 + tid, nthr = (size_t)G * 512;
        p0_convert(p.peer_sub_keys, keys_b, (size_t)PH * 2 * PKEYS * 128, gtid, nthr);
    }
    xcd_barrier(bar);
    PROBE_END

    PROBE_BEGIN(1)
    {
        pg8::Gemm g{(const bf16*)h1_8, (const bf16*)Win8, DM / 2, DM / 2, DM / 2}; pg8::Order<1> S; S.init(SEQ / 256, 56, 1, G, bx, (size_t)256 * DM, 0, (size_t)256 * DM, 0);
        pg8::EpiInProj E{qb, kb, ub, gsb, gpl, 1.0f / 64.0f};
        pg8::gemm_phase<pg8::EpiInProj, pg8::Order<1>, true>(lds, g, S, E, wave);
    }
    {
        pg8::Gemm g{(const bf16*)(Win8 + (size_t)2 * SBW * DM), (const bf16*)h1_8, DM / 2, DM / 2, DM / 2}; pg8::Order<0> S; S.init(SBW / 256, SEQ / 256, 1, G, bx, (size_t)256 * DM, 0, (size_t)256 * DM, 0);
        pg8::EpiB<0> E{vT, SEQ, nullptr, nullptr, nullptr, 1.0f / 64.0f};
        pg8::gemm_phase<pg8::EpiB<0>, pg8::Order<0>, true>(lds, g, S, E, wave);
    }
    xcd_barrier(bar);
    PROBE_END

    PROBE_BEGIN(2)
    {
        pg8::Gemm g{mem_n, Wkv_t, DM, DM, 256}; pg8::Order<0> S; S.init(1, 4, 16, G, bx, 0, 512, (size_t)256 * DM * 2, 512);
        pg8::EpiSlab E{kvs, 2 * XAW, (size_t)MEML * 2 * XAW};
        pg8::gemm_phase(lds, g, S, E, wave);
    }
    if (wave < 4) {
        FRESH_IDS();
        const int gw4 = vcu * 4 + wave, NGW4 = G * 4;
        for (int it = gw4; it < NH * (SEQ / 32); it += NGW4) sb_attn_item(qb, kb, vT, attn, it / (SEQ / 32), it % (SEQ / 32), lane);
        for (int it = gw4; it < (SEQ / 16) * 4; it += NGW4) { const int grp = it & 3, t0 = (it >> 2) * 16, cb = grp * 512;
            if (grp == 0) pool_item<2>(ub, pooled, t0, cb, lane); else if (grp == 1) pool_item<4>(ub, pooled, t0, cb, lane);
            else if (grp == 2) pool_item<8>(ub, pooled, t0, cb, lane); else pool_item<16>(ub, pooled, t0, cb, lane); }
    } else {
        FRESH_IDS();
        const int gw4 = vcu * 4 + (wave - 4), NGW4 = G * 4;
        {
#define QSRC(e_) (((e_) < NEXP) ? p.peer_down + (size_t)(e_) * DM : p.peer_up + (size_t)((e_) - NEXP) * DM)
#define QSCL(e_) (((e_) < NEXP) ? sdown + (e_) : sup + ((e_) - NEXP))
#define QSTORE(v_, e_) do { if ((e_) < NEXP) p0_quant_store(v_, down4 + (size_t)(e_) * ROW4, down6 + (size_t)(e_) * ROW6, QSCL(e_), lane); else p0_quant_store(v_, up4 + (size_t)((e_) - NEXP) * ROW4, up6 + (size_t)((e_) - NEXP) * ROW6, QSCL(e_), lane, up2 + (size_t)((e_) - NEXP) * ROW2, sup2 + ((e_) - NEXP), up1 + (size_t)((e_) - NEXP) * ROW1, sup1 + ((e_) - NEXP)); } while (0)
            f32x4 va[4][4], vb[4][4]; int e = gw4;
            if (e < 2 * NEXP) p0_quant_load(QSRC(e), va, lane);
            for (; e < 2 * NEXP; e += 2 * NGW4) {
                if (e + NGW4 < 2 * NEXP) p0_quant_load(QSRC(e + NGW4), vb, lane);
                QSTORE(va, e);
                if (e + 2 * NGW4 < 2 * NEXP) p0_quant_load(QSRC(e + 2 * NGW4), va, lane);
                if (e + NGW4 < 2 * NEXP) QSTORE(vb, e + NGW4);
            }
#undef QSRC
#undef QSCL
#undef QSTORE
        }
    }
    xcd_barrier(bar);
    PROBE_END

    PROBE_BEGIN(3)
    {
        FRESH_IDS();
        const size_t gtid = (size_t)vcu * 512 + tid, nthr = (size_t)G * 512;
        for (size_t i = gtid; i < (size_t)MEML * 2 * XAW; i += nthr) { float s = 0.f;
#pragma unroll
            for (int k = 0; k < 16; ++k) s += kvs[(size_t)k * MEML * 2 * XAW + i];
            const int m = (int)(i / (2 * XAW)), c = (int)(i % (2 * XAW)); const unsigned short b = (unsigned short)(cvt_pk_bf16(s, 0.f) & 0xffffu);
            if (c < XAW) kvk[(size_t)((c / HD) * MEML + m) * HD + (c % HD)] = b; else { const int cc = c - XAW; kvT[(size_t)((cc / HD) * HD + (cc % HD)) * MEML + m] = b; } }
    }
    {
        pg8::Gemm g{pooled, gw_t, PLW, 512, 512}; pg8::Order<2> S; S.init(SEQ / 256, PLW / 256, 1, G, bx, (size_t)256 * PLW * 2, 0, (size_t)256 * 512 * 2, 0);
        pg8::EpiB<4> E{mixed, PLW, nullptr, nullptr, nullptr, MIXED_SC};
        pg8::gemm_phase(lds, g, S, E, wave);
    }
    {
        pg8::Gemm g{attn, Wsb_t, SBW, SBW, SBW}; pg8::Order<0> S; S.init(SEQ / 256, DM / 256, 1, G, bx, (size_t)256 * SBW * 2, 0, (size_t)256 * SBW * 2, 0);
        pg8::EpiB<2> E{Tb, DM, nullptr, gsb, nullptr, 1.0f};
        pg8::gemm_phase(lds, g, S, E, wave);
    }
    xcd_barrier(bar);
    PROBE_END

    PROBE_BEGIN(4)
    {
        pg8::Gemm g{mixed, Wpool_t, PLW / 2, PLW / 2, PLW / 2}; pg8::Order<0> S; S.init(SEQ / 256, DM / 256, 1, G, bx, (size_t)256 * PLW, 0, (size_t)256 * PLW, 0);
        pg8::EpiB<5> E{gated, DM, nullptr, gpl, Tb, 1.0f / (MIXED_SC * WBR_SC), GATED_SC};
        pg8::gemm_phase<pg8::EpiB<5>, pg8::Order<0>, true>(lds, g, S, E, wave);
    }
    xcd_barrier(bar);
    PROBE_END

    {
        pg8::Gemm g{gated, Wout_t, DM / 2, DM / 2, DM / 2}; pg8::Order<0> S; S.init(SEQ / 256, DM / 256, 1, G, bx, (size_t)256 * DM, 0, (size_t)256 * DM, 0);
        pg8::EpiRes<false> E{p.x, nullptr, xb, ss2, 1.0f / (GATED_SC * WBR_SC)};
        pg8::gemm_phase<pg8::EpiRes<false>, pg8::Order<0>, true>(lds, g, S, E, wave);
    }
    xcd_barrier(bar);

    PROBE_BEGIN(6)
    {
        pg8::Gemm g{xb, Wxq_t, DM, DM, 1024}; pg8::Order<0> S; S.init(SEQ / 256, XAW / 256, 4, G, bx, (size_t)256 * DM * 2, 2048, (size_t)256 * DM * 2, 2048);
        pg8::EpiSlab E{xqs, XAW, (size_t)SEQ * XAW};
        pg8::gemm_phase(lds, g, S, E, wave);
    }
    xcd_barrier(bar);
    PROBE_END
    PROBE_BEGIN(7)
    {
        FRESH_IDS();
        const int h = bx & 3, j = bx >> 2, NJ = (G + 3 - h) >> 2;
        for (int idx = tid; idx < MEML * 16; idx += 512) { const int row = idx >> 4, c = idx & 15; *(LAS u32x4*)(lds + row * XK_STRIDE + c * 16) = *(const u32x4*)(kvk + (size_t)(h * MEML + row) * HD + c * 8); }
        for (int idx = tid; idx < HD * 32; idx += 512) { const int row = idx >> 5, c = idx & 31; const u32x4 v = *(const u32x4*)(kvT + (size_t)(h * HD + row) * MEML + c * 8);
            LAS u32x2* d = (LAS u32x2*)(lds + XV_OFF + row * XV_STRIDE + c * 16); d[0] = (u32x2){v.x, v.y}; d[1] = (u32x2){v.z, v.w}; }
        __syncthreads();
        for (int tt = j + NJ * wave; tt < SEQ / 32; tt += NJ * 8) xattn_item(xqs, ss2, lds, lds + XV_OFF, ob, h, tt, lane);
    }
    xcd_barrier(bar);
    PROBE_END
    {
        pg8::Gemm g{ob, Wxo_t, XAW, XAW, XAW}; pg8::Order<0> S; S.init(SEQ / 256, DM / 256, 1, G, bx, (size_t)256 * XAW * 2, 0, (size_t)256 * XAW * 2, 0);
        pg8::EpiRes<true> E{nullptr, xb, xb, ss3};
        pg8::gemm_phase(lds, g, S, E, wave);
    }
    xcd_barrier(bar);

    PROBE_BEGIN(9)
    {
        pg8::Gemm g{xb, Wpq_t, DM, DM, DM}; pg8::Order<0> S; S.init(SEQ / 256, PQW / 256, 1, G, bx, (size_t)256 * DM * 2, 0, (size_t)256 * DM * 2, 0);
        pg8::EpiB<1> E{pqb, PQW, ss3, nullptr, nullptr, 1.0f};
        pg8::gemm_phase(lds, g, S, E, wave);
    }
    xcd_barrier(bar);
    PROBE_END
    PROBE_BEGIN(10)
    { FRESH_IDS(); for (int it = vcu * 8 + wave; it < PH * (SEQ / 32); it += NGW) route_item(pqb, keys_b, eid, gate, it % PH, it / PH, lane); }
    xcd_barrier(bar);
    PROBE_END
    { const bool poisoned = xb_ld(ctl + CW_BAR + XB_TMO) != 0u;
      for (int t = gw; t < SEQ; t += NGW) { const int lane = fresh_lane();
          peer_token(xb + (size_t)t * DM, ss3[t], p.norm_ffn, p.norm_final, down4, down6, up4, up6, up2, up1, sdown, sup, sup2, sup1, eid + (size_t)t * 128, gate + (size_t)t * 128, p.out + (size_t)t * DM, lane);
          if (poisoned) p.out[(size_t)t * DM + lane] = __builtin_nanf(""); } }
}

extern "C" void kernel_launch(void* const* d_in, const int* in_sizes, int n_in, void* d_out, int out_size, void* d_ws, size_t ws_size, hipStream_t stream) {
    static int grid = 0;
    if (grid == 0) {
        if (n_in != 20 || out_size != SEQ * DM || ws_size < WS_END) { fprintf(stderr, "kernel_launch: unexpected problem (n_in %d, out %d, ws %zu)\n", n_in, out_size, ws_size); grid = -1; return; }
        int dev = 0, cus = 0, per_cu = 0;
        if (hipGetDevice(&dev) != hipSuccess || hipDeviceGetAttribute(&cus, hipDeviceAttributeMultiprocessorCount, dev) != hipSuccess) { grid = -1; return; }
        if (hipFuncSetAttribute((const void*)fwd, hipFuncAttributeMaxDynamicSharedMemorySize, LDS_BYTES) != hipSuccess) { fprintf(stderr, "kernel_launch: hipFuncSetAttribute failed\n"); grid = -1; return; }
        if (hipOccupancyMaxActiveBlocksPerMultiprocessor(&per_cu, (const void*)fwd, 512, LDS_BYTES) != hipSuccess || per_cu < 1) fprintf(stderr, "kernel_launch: occupancy query reports %d\n", per_cu);
        (void)hipGetLastError();
        grid = cus;
    }
    if (grid < 0) return;
    if (hipMemsetAsync((char*)d_ws + WS_CTL, 0, CTL_BYTES, stream) != hipSuccess) return;
    Params p{};
    const float** pp = (const float**)&p;
    for (int i = 0; i < 20; ++i) pp[i] = (const float*)d_in[i];
    p.out = (float*)d_out; p.ws = (unsigned char*)d_ws;
    hipLaunchKernelGGL(fwd, dim3(grid), dim3(512), LDS_BYTES, stream, p);
}
```

```cpp
#include <hip/hip_runtime.h>
#include <cstdio>
#include <cstdint>


#ifndef PROBE_PHASE
#define PROBE_PHASE -1
#endif
#define PROBE_BEGIN(k) _Pragma("unroll 1") for (int rep_ = 0; rep_ < ((PROBE_PHASE == (k)) ? 2 : 1); ++rep_) {
#define PROBE_END }

#define LAS __attribute__((address_space(3)))
#define GAS __attribute__((address_space(1)))
typedef unsigned short bf16;
typedef short bf16x8 __attribute__((ext_vector_type(8)));
typedef short s16x4 __attribute__((ext_vector_type(4)));
typedef float f32x2 __attribute__((ext_vector_type(2)));
typedef float f32x4 __attribute__((ext_vector_type(4)));
typedef float f32x16 __attribute__((ext_vector_type(16)));
typedef unsigned u32x2 __attribute__((ext_vector_type(2)));
typedef unsigned u32x4 __attribute__((ext_vector_type(4)));
typedef unsigned u32x6 __attribute__((ext_vector_type(6)));
typedef float f32x32 __attribute__((ext_vector_type(32)));

constexpr int SEQ = 8192, DM = 4096, INW = 16384, SBW = 2048, PLW = 2048, NH = 16, HD = 128;
constexpr int MEML = 256, XAW = 512, XAH = 4;
constexpr int NEXP = 16384, PH = 8, PQW = 2048, PKEYS = 128, TOPK = 16;
constexpr float EPS = 1e-6f;
constexpr int ROW6 = DM * 6 / 8;
constexpr int ROW4 = DM / 2;
constexpr float LOG2E = 1.4426950408889634f, LN2 = 0.6931471805599453f;

constexpr size_t MiB = 1u << 20;
constexpr size_t WS_CTL = 0, CTL_BYTES = 2 * MiB;
constexpr size_t WS_WIN = 2 * MiB;
constexpr size_t WS_T = 2 * MiB, WS_GATED = 66 * MiB;
constexpr size_t WS_WSB = 130 * MiB, WS_WPOOL = 146 * MiB, WS_WOUT = 162 * MiB, WS_WXQ = 194 * MiB, WS_WKV = 198 * MiB, WS_WXO = 206 * MiB, WS_WPQ = 210 * MiB;
constexpr size_t WS_GW = 226 * MiB, WS_KEYS = 228 * MiB, WS_MEMN = 229 * MiB, WS_KVB = 231 * MiB;
constexpr size_t WS_DOWN4 = 232 * MiB, WS_DOWN6 = 264 * MiB, WS_UP4 = 360 * MiB, WS_UP6 = 392 * MiB;
constexpr size_t WS_UP2 = 824 * MiB, WS_SUP2 = 322 * MiB;
constexpr int ROW2 = DM / 4;
constexpr size_t WS_UP1 = 840 * MiB, WS_SUP1 = 323 * MiB;
constexpr int ROW1 = DM / 8;
constexpr size_t WS_SDOWN = 320 * MiB, WS_SUP = 321 * MiB;
constexpr size_t WS_H1 = 488 * MiB;
constexpr size_t WS_ATTN = 488 * MiB, WS_POOLED = 520 * MiB, WS_XB = 488 * MiB;
constexpr size_t WS_Q = 552 * MiB, WS_K = 584 * MiB, WS_VT = 616 * MiB, WS_UB = 648 * MiB, WS_GSB = 680 * MiB, WS_GPL = 744 * MiB;
constexpr size_t WS_MIXED = WS_Q, WS_PQ = WS_K, WS_EID = WS_VT, WS_GATE = WS_VT + 4 * MiB, WS_XQS = WS_GSB, WS_O = WS_GPL;
constexpr size_t WS_KVS = 808 * MiB, WS_END = 848 * MiB;
constexpr int CW_BAR = 4096;
constexpr size_t CTL_SS2 = 1 * MiB, CTL_SS3 = 1 * MiB + 64 * 1024;

constexpr int RING_BYTES = 131072;
constexpr int LDSCTL_OFF = 136 * 1024, MISC_OFF = LDSCTL_OFF + 320;
constexpr int LDS_BYTES = 147456;

#define LDS_WAIT() asm volatile("s_waitcnt lgkmcnt(0)" ::: "memory")
#define VM_WAIT() asm volatile("s_waitcnt vmcnt(0)" ::: "memory")
__device__ __forceinline__ int fresh_lane() { int l; asm volatile("v_mbcnt_lo_u32_b32 %0, -1, 0\n\tv_mbcnt_hi_u32_b32 %0, -1, %0" : "=v"(l)); return l; }
#define FRESH_IDS() const int lane = fresh_lane(); const int tid = wave * 64 + lane; (void)tid

__device__ __forceinline__ unsigned cvt_pk_bf16(float lo, float hi) { unsigned r; asm volatile("v_cvt_pk_bf16_f32 %0, %1, %2" : "=v"(r) : "v"(lo), "v"(hi)); return r; }
__device__ __forceinline__ float bf_lo(unsigned w) { return __builtin_bit_cast(float, w << 16); }
__device__ __forceinline__ float bf_hi(unsigned w) { return __builtin_bit_cast(float, w & 0xffff0000u); }
__device__ __forceinline__ float wave_sum(float v) {
#pragma unroll
    for (int o = 1; o < 64; o <<= 1) v += __shfl_xor(v, o);
    return v;
}
__device__ __forceinline__ u32x4 ld16(const void* sbase, unsigned voff, int imm = 0) { return *(const u32x4*)(((const char*)sbase + voff) + imm); }
__device__ __forceinline__ f32x4 ld16f(const void* sbase, unsigned voff, int imm = 0) { return *(const f32x4*)(((const char*)sbase + voff) + imm); }
__device__ __forceinline__ u32x2 ld8(const void* sbase, unsigned voff, int imm = 0) { return *(const u32x2*)(((const char*)sbase + voff) + imm); }
__device__ __forceinline__ float xchg32(float x, int hh) { const unsigned u = __builtin_bit_cast(unsigned, x); auto r = __builtin_amdgcn_permlane32_swap(u, u, false, false); return __builtin_bit_cast(float, hh ? r[0] : r[1]); }
__device__ __forceinline__ float xchg16(float x, int q) { const unsigned u = __builtin_bit_cast(unsigned, x); auto r = __builtin_amdgcn_permlane16_swap(u, u, false, false); return __builtin_bit_cast(float, q ? r[0] : r[1]); }
__device__ __forceinline__ float row_sum16(float v) {
    v += __builtin_bit_cast(float, __builtin_amdgcn_update_dpp(0, __builtin_bit_cast(int, v), 0x128, 0xf, 0xf, false));
    v += __builtin_bit_cast(float, __builtin_amdgcn_update_dpp(0, __builtin_bit_cast(int, v), 0x124, 0xf, 0xf, false));
    v += __builtin_bit_cast(float, __builtin_amdgcn_update_dpp(0, __builtin_bit_cast(int, v), 0x122, 0xf, 0xf, false));
    v += __builtin_bit_cast(float, __builtin_amdgcn_update_dpp(0, __builtin_bit_cast(int, v), 0x121, 0xf, 0xf, false));
    return v; }
__device__ __forceinline__ float wave_sum_x(float v, int lane) { v = row_sum16(v); v += xchg16(v, (lane >> 4) & 1); v += xchg32(v, lane >> 5); return v; }
__device__ __forceinline__ float wave_max_x(float v, int lane) {
    v = __builtin_fmaxf(v, __builtin_bit_cast(float, __builtin_amdgcn_update_dpp(0, __builtin_bit_cast(int, v), 0x128, 0xf, 0xf, false)));
    v = __builtin_fmaxf(v, __builtin_bit_cast(float, __builtin_amdgcn_update_dpp(0, __builtin_bit_cast(int, v), 0x124, 0xf, 0xf, false)));
    v = __builtin_fmaxf(v, __builtin_bit_cast(float, __builtin_amdgcn_update_dpp(0, __builtin_bit_cast(int, v), 0x122, 0xf, 0xf, false)));
    v = __builtin_fmaxf(v, __builtin_bit_cast(float, __builtin_amdgcn_update_dpp(0, __builtin_bit_cast(int, v), 0x121, 0xf, 0xf, false)));
    v = __builtin_fmaxf(v, xchg16(v, (lane >> 4) & 1)); v = __builtin_fmaxf(v, xchg32(v, lane >> 5)); return v; }
__device__ __forceinline__ float fexp2(float x) { return __builtin_amdgcn_exp2f(x); }
__device__ __forceinline__ float flog2(float x) { return __builtin_amdgcn_logf(x); }
__device__ __forceinline__ float frcp(float x) { return __builtin_amdgcn_rcpf(x); }

#define XB_TMO      128
#define XB_XCNT(j)  (256  + 64 * (j))
#define XB_XSUB(j)  (1280 + 64 * (j))
#define XB_XGEN(j)  (2304 + 64 * (j))
#define XB_TOP      3328
#define XB_TOPGEN   3392
#define XCD_BAR_WORDS 3456
#define XB_SPIN_CAP (1u << 18)
__device__ __forceinline__ unsigned xb_ld(unsigned* p)              { return __hip_atomic_load(p, __ATOMIC_RELAXED, __HIP_MEMORY_SCOPE_AGENT); }
__device__ __forceinline__ unsigned xb_add(unsigned* p, unsigned v) { return __hip_atomic_fetch_add(p, v, __ATOMIC_RELAXED, __HIP_MEMORY_SCOPE_AGENT); }
__device__ __forceinline__ unsigned xb_xcc_id() { return (unsigned)__builtin_amdgcn_s_getreg((3 << 11) | 20) & 0xFu; }
#define XB_SPIN(cond, bar) do { unsigned _sp = 0; while (cond) { __builtin_amdgcn_s_sleep(1); \
    if ((++_sp & 255u) == 0u) { if (xb_ld(&(bar)[XB_TMO])) break; if (_sp > XB_SPIN_CAP) { atomicAdd(&(bar)[XB_TMO], 1u); break; } } } } while (0)
struct XcdBarrier { unsigned* bar; unsigned x; volatile LAS unsigned* st; int wave; };
__device__ __forceinline__ XcdBarrier xcd_barrier_post(unsigned* bar, volatile LAS unsigned* st, int wave) {
    XcdBarrier b; b.bar = bar; b.x = xb_xcc_id(); b.st = st; b.wave = wave;
    if (threadIdx.x == 0) (void)xb_add(&bar[XB_XCNT(b.x)], 1u);
    return b;
}
__device__ __forceinline__ void xcd_barrier_complete(unsigned* bar, unsigned x, unsigned& nloc, unsigned& nx) {
    const unsigned G = gridDim.x * gridDim.y * gridDim.z;
    unsigned sum, cnt, mine, sp = 0u;
    for (;;) {
        sum = 0u; cnt = 0u; mine = 0u;
#pragma unroll
        for (unsigned j = 0; j < 16; ++j) { const unsigned c = xb_ld(&bar[XB_XCNT(j)]); sum += c; cnt += (c > 0u) ? 1u : 0u; mine = (j == x) ? c : mine; }
        if (sum == G) break;
        __builtin_amdgcn_s_sleep(1);
        if ((++sp & 255u) == 0u) { if (xb_ld(&bar[XB_TMO])) break; if (sp > XB_SPIN_CAP) { atomicAdd(&bar[XB_TMO], 1u); break; } }
    }
    nloc = mine > 0u ? mine : 1u; nx = cnt > 0u ? cnt : 1u;
}
__device__ __forceinline__ void xcd_barrier(const XcdBarrier& b) {
    asm volatile("s_waitcnt vmcnt(0)" ::: "memory");
    __syncthreads();
    if (b.wave == 0 && fresh_lane() == 0) {
        unsigned* bar = b.bar;
        __builtin_amdgcn_s_waitcnt(0);
        unsigned nloc = b.st[0], nx = b.st[1];
        if (nloc == 0u) { xcd_barrier_complete(bar, b.x, nloc, nx); b.st[0] = nloc; b.st[1] = nx; }
        const unsigned old = xb_add(&bar[XB_XSUB(b.x)], 1u);
        const unsigned gen = old / nloc;
        if (old + 1u == (gen + 1u) * nloc) {
            __builtin_amdgcn_fence(__ATOMIC_RELEASE, "agent");
            asm volatile("s_waitcnt vmcnt(0)" ::: "memory");
            const unsigned og = xb_add(&bar[XB_TOP], 1u);
            const unsigned tg = og / nx;
            if (og + 1u == (tg + 1u) * nx) xb_add(&bar[XB_TOPGEN], 1u);
            else XB_SPIN(xb_ld(&bar[XB_TOPGEN]) == tg, bar);
            __builtin_amdgcn_fence(__ATOMIC_ACQUIRE, "agent");
            xb_add(&bar[XB_XGEN(b.x)], 1u);
            asm volatile("s_waitcnt vmcnt(0)" ::: "memory");
        } else {
            XB_SPIN(xb_ld(&bar[XB_XGEN(b.x)]) == gen, bar);
            __builtin_amdgcn_fence(__ATOMIC_ACQUIRE, "agent");
            asm volatile("s_waitcnt vmcnt(0)" ::: "memory");
        }
    }
    __syncthreads();
}

namespace pg8 {
constexpr int BM = 256, BK = 64, HALF = 128, HTB = HALF * BK * 2, STAGE_BYTES = 8 * HTB, NXCD = 8, WGM = 8;
__host__ __device__ __forceinline__ int lds_byte(int r, int c) { const int st = (r >> 4) * 2 + (c >> 5), rr = r & 15, cc = c & 31, ob = rr * 64 + cc * 2; return st * 1024 + (ob ^ (((ob >> 9) & 1) << 5)); }
__host__ __device__ __forceinline__ void stage_rc(int b, int& R, int& C) { const int st = b / 1024, sb = b % 1024, swz = sb ^ (((sb >> 9) & 1) << 5); R = (st >> 1) * 16 + swz / 64; C = (st & 1) * 32 + (swz % 64) / 2; }
__host__ __device__ __forceinline__ int perm32(int rho) { const int n = rho >> 4, i = rho & 15; return 8 * (i >> 2) + 4 * n + (i & 3); }

typedef int i32x8 __attribute__((ext_vector_type(8))); typedef int i32x4 __attribute__((ext_vector_type(4)));
__device__ __forceinline__ i32x8 cat8(const bf16x8 lo, const bf16x8 hi) { const i32x4 a = __builtin_bit_cast(i32x4, lo), b = __builtin_bit_cast(i32x4, hi); return __builtin_shufflevector(a, b, 0, 1, 2, 3, 4, 5, 6, 7); }
struct GUnit { int pm, pn, ks; size_t aoff, boff; };
struct Gemm { const bf16* A; const bf16* Bt; int lda, ldb, K; };

template <int MODE> struct Order {
    int nM, nN, nKs, nwg, G, c; size_t a_pm, a_ks, b_pn, b_ks;
    __device__ __forceinline__ void init(int nM_, int nN_, int nKs_, int G_, int c_, size_t a_pm_, size_t a_ks_, size_t b_pn_, size_t b_ks_) {
        nM = nM_; nN = nN_; nKs = nKs_; nwg = nM * nN; G = G_; c = c_; a_pm = a_pm_; a_ks = a_ks_; b_pn = b_pn_; b_ks = b_ks_; }
    __device__ __forceinline__ bool next(int i, GUnit& u) const {
        const long L = (long)i * G + c; if (L >= (long)nwg * nKs) return false;
        const int ks = (int)(L / nwg); int wgid = (int)(L % nwg);
        { const int q = nwg / NXCD, r = nwg % NXCD, xcd = wgid % NXCD, off = wgid / NXCD; wgid = (xcd < r ? xcd * (q + 1) : r * (q + 1) + (xcd - r) * q) + off; }
        const int nig = WGM * nN, gid = wgid / nig, fm = gid * WGM, gsz = (nM - fm) < WGM ? (nM - fm) : WGM;
        int pm = fm + ((wgid % nig) % gsz), pn = (wgid % nig) / gsz;
        if (MODE == 1) pn = pn < 16 ? pn : pn + 8;
        u.pm = pm; u.pn = pn; u.ks = ks;
        u.aoff = (size_t)pm * a_pm + (size_t)ks * a_ks + (MODE == 2 ? (size_t)(pn >> 1) * 1024 : 0);
        u.boff = (size_t)pn * b_pn + (size_t)ks * b_ks;
        return true;
    }
    __device__ __forceinline__ void a_ready(const GUnit&) const {}
    __device__ __forceinline__ void done(const GUnit&) const {}
};

template <class Epi, class Sched, bool FP8 = false, bool ALIGN_EPI = true, bool SP2 = true>
__device__ __forceinline__ void gemm_phase(LAS unsigned char* lds, const Gemm g, const Sched& S, const Epi& E, const int wave_id) {
    const int lane = fresh_lane(), wid = wave_id, tid = wid * 64 + lane, wr = wid >> 2, wc = wid & 3, fr = lane & 15, fq = lane >> 4;
    const int K = g.K, nt = K / BK;
    unsigned voffA[2], voffB[2];
#pragma unroll
    for (int i = 0; i < 2; ++i) { int R, C; stage_rc(tid * 16 + i * 8192, R, C); const int Rb = (R & ~31) + perm32(R & 31);
        voffA[i] = (unsigned)(R * g.lda + C) * 2u; voffB[i] = (unsigned)(Rb * g.ldb + C) * 2u; }
    const size_t kstep = (size_t)(BK * 2);
    const size_t hstepA = (size_t)HALF * g.lda * 2, hstepB = (size_t)HALF * g.ldb * 2;
    const unsigned ldsw = (unsigned)wid * 1024u;
    const int aoff = lds_byte(wr * 64 + fr, fq * 8), boff = lds_byte(wc * 32 + fr, fq * 8);
#define PG8_SA(b, h) (((b) * 2 + (h)) * HTB)
#define PG8_SB(b, h) ((4 + (b) * 2 + (h)) * HTB)
#define PG8_STAGE(bufoff, gbase, voff) do { _Pragma("unroll") for (int _i = 0; _i < 2; ++_i) \
        __builtin_amdgcn_global_load_lds((const unsigned*)((const char*)(gbase) + (voff)[_i]), (LAS unsigned*)(lds + (bufoff) + ldsw + _i * 8192), 16, 0, 0); } while (0)
#define PG8_LD16(off) (*(const LAS bf16x8*)(lds + (off)))
#define PG8_LDA(dst, b, h) do { _Pragma("unroll") for (int m = 0; m < 4; ++m) { if constexpr (FP8) dst##8[m] = cat8(PG8_LD16(PG8_SA(b, h) + aoff + m * 2048), PG8_LD16(PG8_SA(b, h) + aoff + m * 2048 + 1024)); \
        else { _Pragma("unroll") for (int k = 0; k < 2; ++k) dst[m][k] = PG8_LD16(PG8_SA(b, h) + aoff + m * 2048 + k * 1024); } } } while (0)
#define PG8_LDB(dst, b, h) do { _Pragma("unroll") for (int n = 0; n < 2; ++n) { if constexpr (FP8) dst##8[n] = cat8(PG8_LD16(PG8_SB(b, h) + boff + n * 2048), PG8_LD16(PG8_SB(b, h) + boff + n * 2048 + 1024)); \
        else { _Pragma("unroll") for (int k = 0; k < 2; ++k) dst[n][k] = PG8_LD16(PG8_SB(b, h) + boff + n * 2048 + k * 1024); } } } while (0)
#define PG8_MMA(ai, bj, At, Bt) do { __builtin_amdgcn_s_setprio(1); _Pragma("unroll") for (int m = 0; m < 4; ++m) _Pragma("unroll") for (int n = 0; n < 2; ++n) { \
        if constexpr (FP8) asm volatile("v_mfma_scale_f32_16x16x128_f8f6f4 %0, %1, %2, %0, %3, %3 op_sel_hi:[0,0,0]" : "+v"(acc[ai][bj][m][n]) : "v"(Bt##8[n]), "v"(At##8[m]), "v"(one_scale)); \
        else { _Pragma("unroll") for (int k = 0; k < 2; ++k) acc[ai][bj][m][n] = __builtin_amdgcn_mfma_f32_16x16x32_bf16(Bt[n][k], At[m][k], acc[ai][bj][m][n], 0, 0, 0); } } __builtin_amdgcn_s_setprio(0); } while (0)
#define PG8_WAIT_V(n) asm volatile("s_waitcnt vmcnt(" #n ")" ::: "memory")
#define PG8_WAIT_L(n) asm volatile("s_waitcnt lgkmcnt(" #n ")" ::: "memory")
#define PG8_BAR __builtin_amdgcn_s_barrier()
#define PG8_SCHED __builtin_amdgcn_sched_barrier(0)
    GUnit cur, nxt; int ui = 0;
    if (!S.next(0, cur)) return;
    f32x4 acc[2][2][4][2];
#pragma unroll
    for (int a = 0; a < 2; ++a)
#pragma unroll
        for (int b = 0; b < 2; ++b)
#pragma unroll
            for (int m = 0; m < 4; ++m)
#pragma unroll
                for (int n = 0; n < 2; ++n) acc[a][b][m][n] = (f32x4){0.f, 0.f, 0.f, 0.f};
    const int one_scale = 0x7f7f7f7f;
    bf16x8 At[4][2], B0[2][2], B1[2][2]; i32x8 At8[4], B08[2], B18[2];
    const char* cA = (const char*)g.A + cur.aoff; const char* cB = (const char*)g.Bt + cur.boff;
    S.a_ready(cur);
    if constexpr (SP2) {
        PG8_STAGE(PG8_SB(0, 0), cB, voffB); PG8_STAGE(PG8_SB(0, 1), cB + hstepB, voffB); PG8_STAGE(PG8_SA(0, 0), cA, voffA); PG8_STAGE(PG8_SA(0, 1), cA + hstepA, voffA);
        if (wr == 1) PG8_BAR;
        PG8_WAIT_V(2); PG8_BAR;
        PG8_STAGE(PG8_SB(1, 0), cB + kstep, voffB); PG8_STAGE(PG8_SA(1, 0), cA + kstep, voffA); PG8_STAGE(PG8_SB(1, 1), cB + hstepB + kstep, voffB);
        PG8_WAIT_V(6); PG8_BAR;
    } else {
        PG8_STAGE(PG8_SB(0, 0), cB, voffB); PG8_STAGE(PG8_SA(0, 0), cA, voffA); PG8_STAGE(PG8_SB(0, 1), cB + hstepB, voffB); PG8_STAGE(PG8_SA(0, 1), cA + hstepA, voffA);
        if (wr == 1) PG8_BAR;
        PG8_WAIT_V(4); PG8_BAR;
        PG8_STAGE(PG8_SB(1, 0), cB + kstep, voffB); PG8_STAGE(PG8_SA(1, 0), cA + kstep, voffA); PG8_STAGE(PG8_SB(1, 1), cB + hstepB + kstep, voffB);
        PG8_WAIT_V(6); PG8_BAR;
    }
    for (;;) {
        const bool has_next = S.next(ui + 1, nxt);
        const char* nA = has_next ? (const char*)g.A + nxt.aoff : cA; const char* nB = has_next ? (const char*)g.Bt + nxt.boff : cB;
        for (int t = 0; t < nt; t += 2) {
            const bool last = (t == nt - 2);
            const char* a1 = cA + (size_t)(t + 1) * kstep;
            const char* a2 = last ? nA : cA + (size_t)(t + 2) * kstep; const char* b2 = last ? nB : cB + (size_t)(t + 2) * kstep;
            const char* a3 = a2 + kstep; const char* b3 = b2 + kstep;
            if (last && has_next) S.a_ready(nxt);
            if constexpr (SP2) {
            PG8_LDB(B0, 0, 0); PG8_LDB(B1, 0, 1); PG8_SCHED; PG8_LDA(At, 0, 0); PG8_STAGE(PG8_SA(1, 1), a1 + hstepA, voffA);
            PG8_WAIT_V(8); PG8_WAIT_L(0); PG8_BAR; PG8_MMA(0, 0, At, B0); PG8_MMA(0, 1, At, B1); PG8_BAR; PG8_SCHED;
            PG8_LDA(At, 0, 1); PG8_STAGE(PG8_SB(0, 0), b2, voffB); PG8_STAGE(PG8_SB(0, 1), b2 + hstepB, voffB); PG8_STAGE(PG8_SA(0, 0), a2, voffA);
            PG8_WAIT_V(8); PG8_WAIT_L(0); PG8_BAR; PG8_MMA(1, 0, At, B0); PG8_MMA(1, 1, At, B1); PG8_BAR; PG8_SCHED;
            PG8_LDB(B0, 1, 0); PG8_LDB(B1, 1, 1); PG8_SCHED; PG8_LDA(At, 1, 0); PG8_STAGE(PG8_SA(0, 1), a2 + hstepA, voffA);
            PG8_WAIT_V(8); PG8_WAIT_L(0); PG8_BAR; PG8_MMA(0, 0, At, B0); PG8_MMA(0, 1, At, B1); PG8_BAR; PG8_SCHED;
            PG8_LDA(At, 1, 1); PG8_STAGE(PG8_SB(1, 0), b3, voffB); PG8_STAGE(PG8_SB(1, 1), b3 + hstepB, voffB); PG8_STAGE(PG8_SA(1, 0), a3, voffA);
            PG8_WAIT_V(8); PG8_WAIT_L(0); PG8_BAR; PG8_MMA(1, 0, At, B0); PG8_MMA(1, 1, At, B1); PG8_BAR; PG8_SCHED;
            } else {
            PG8_LDB(B0, 0, 0); PG8_SCHED; PG8_LDA(At, 0, 0); PG8_STAGE(PG8_SA(1, 1), a1 + hstepA, voffA);
            PG8_WAIT_L(8); PG8_BAR; PG8_WAIT_L(0); PG8_MMA(0, 0, At, B0); PG8_BAR; PG8_SCHED;
            PG8_LDB(B1, 0, 1); PG8_STAGE(PG8_SB(0, 0), b2, voffB);
            PG8_BAR; PG8_WAIT_L(0); PG8_MMA(0, 1, At, B1); PG8_BAR;
            PG8_LDA(At, 0, 1); PG8_STAGE(PG8_SA(0, 0), a2, voffA);
            PG8_BAR; PG8_WAIT_L(0); PG8_MMA(1, 0, At, B0); PG8_BAR; PG8_SCHED;
            PG8_STAGE(PG8_SB(0, 1), b2 + hstepB, voffB);
            PG8_WAIT_V(6); PG8_BAR; PG8_MMA(1, 1, At, B1); PG8_BAR;
            PG8_LDB(B0, 1, 0); PG8_SCHED; PG8_LDA(At, 1, 0); PG8_STAGE(PG8_SA(0, 1), a2 + hstepA, voffA);
            PG8_WAIT_L(8); PG8_BAR; PG8_WAIT_L(0); PG8_MMA(0, 0, At, B0); PG8_BAR; PG8_SCHED;
            PG8_LDB(B1, 1, 1); PG8_STAGE(PG8_SB(1, 0), b3, voffB);
            PG8_BAR; PG8_WAIT_L(0); PG8_MMA(0, 1, At, B1); PG8_BAR;
            PG8_LDA(At, 1, 1); PG8_STAGE(PG8_SA(1, 0), a3, voffA);
            PG8_BAR; PG8_WAIT_L(0); PG8_MMA(1, 0, At, B0); PG8_BAR; PG8_SCHED;
            PG8_STAGE(PG8_SB(1, 1), b3 + hstepB, voffB);
            PG8_WAIT_V(6); PG8_BAR; PG8_MMA(1, 1, At, B1); PG8_BAR;
            }
        }
        if constexpr (ALIGN_EPI) { if (wr == 0) PG8_BAR; }
        if constexpr (FP8) asm volatile("s_nop 15\n\ts_nop 15\n\ts_nop 15" ::: "memory");
        { const int l_e = fresh_lane();
          E(acc, cur, wr, wc, l_e & 15, l_e >> 4); } S.done(cur);
        if (!has_next) break;
#pragma unroll
        for (int a = 0; a < 2; ++a)
#pragma unroll
            for (int b = 0; b < 2; ++b)
#pragma unroll
                for (int m = 0; m < 4; ++m)
#pragma unroll
                    for (int n = 0; n < 2; ++n) acc[a][b][m][n] = (f32x4){0.f, 0.f, 0.f, 0.f};
        cur = nxt; cA = nA; cB = nB; ++ui;
        if constexpr (ALIGN_EPI) { if (wr == 1) PG8_BAR; }
    }
    PG8_WAIT_V(0);
    if constexpr (!ALIGN_EPI) { if (wr == 0) PG8_BAR; }
    PG8_BAR;
#undef PG8_SA
#undef PG8_SB
#undef PG8_STAGE
#undef PG8_LDA
#undef PG8_LDB
#undef PG8_MMA
#undef PG8_WAIT_V
#undef PG8_WAIT_L
#undef PG8_BAR
#undef PG8_SCHED
}

#define EPI_LOOP_ROWS for (int ai = 0; ai < 2; ++ai) _Pragma("unroll") for (int m = 0; m < 4; ++m)
__device__ __forceinline__ u32x4 pack8(const f32x4 v0, const f32x4 v1) { u32x4 w; w.x = cvt_pk_bf16(v0[0], v0[1]); w.y = cvt_pk_bf16(v0[2], v0[3]); w.z = cvt_pk_bf16(v1[0], v1[1]); w.w = cvt_pk_bf16(v1[2], v1[3]); return w; }
__device__ __forceinline__ void unpack8(const u32x4 w, f32x4& v0, f32x4& v1) { v0 = (f32x4){bf_lo(w.x), bf_hi(w.x), bf_lo(w.y), bf_hi(w.y)}; v1 = (f32x4){bf_lo(w.z), bf_hi(w.z), bf_lo(w.w), bf_hi(w.w)}; }
__device__ __forceinline__ f32x4 sigmoid4(const f32x4 v) { f32x4 r;
#pragma unroll
    for (int j = 0; j < 4; ++j) r[j] = frcp(1.0f + fexp2(-v[j] * LOG2E));
    return r; }

struct EpiInProj {
    bf16 *qb, *kb, *ub, *gsb, *gpl; float sc;
    __device__ __forceinline__ void operator()(const f32x4 (&acc)[2][2][4][2], const GUnit& u, int wr, int wc, int fr, int fq) const {
        const int pn = u.pn; bf16* base; int ldc, ct; bool sig = false;
        if (pn < 8) { base = qb; ldc = SBW; ct = pn; }
        else if (pn < 16) { base = kb; ldc = SBW; ct = pn - 8; }
        else if (pn < 32) { base = ub; ldc = PLW; ct = pn - 24; }
        else if (pn < 48) { base = gsb; ldc = DM; ct = pn - 32; sig = true; }
        else { base = gpl; ldc = DM; ct = pn - 48; sig = true; }
        const int row0 = u.pm * BM + wr * 64 + fr, col0 = ct * BM + wc * 32 + 8 * fq;
#pragma unroll
        EPI_LOOP_ROWS { bf16* rowp = base + (size_t)(row0 + ai * HALF + m * 16) * ldc + col0;
#pragma unroll
            for (int bj = 0; bj < 2; ++bj) { f32x4 v0 = acc[ai][bj][m][0] * sc, v1 = acc[ai][bj][m][1] * sc;
                if (sig) { v0 = sigmoid4(v0); v1 = sigmoid4(v1); }
                *(u32x4*)(rowp + bj * HALF) = pack8(v0, v1); } }
    }
};
template <int KIND> struct EpiB {
    bf16* O; int ldc; const float* ss; const bf16* g1; const bf16* t; float sc; float osc = 1.0f;
    __device__ __forceinline__ void operator()(const f32x4 (&acc)[2][2][4][2], const GUnit& u, int wr, int wc, int fr, int fq) const {
        const int row0 = u.pm * BM + wr * 64 + fr, col0 = u.pn * BM + wc * 32 + 8 * fq;
#pragma unroll
        EPI_LOOP_ROWS { const int row = row0 + ai * HALF + m * 16; const size_t off = (size_t)row * ldc + col0;
            float rs = 1.f; if (KIND == 1) rs = __builtin_amdgcn_rsqf(ss[row] * (1.0f / DM) + EPS);
#pragma unroll
            for (int bj = 0; bj < 2; ++bj) { f32x4 v0 = acc[ai][bj][m][0], v1 = acc[ai][bj][m][1];
                if (KIND == 0 || KIND == 2 || KIND == 3 || KIND == 4 || KIND == 5) { v0 = v0 * sc; v1 = v1 * sc; }
                if (KIND == 1) { v0 = v0 * rs; v1 = v1 * rs; }
                if (KIND == 2 || KIND == 3 || KIND == 5) { f32x4 a0, a1; unpack8(*(const u32x4*)(g1 + off + bj * HALF), a0, a1); v0 = v0 * a0; v1 = v1 * a1; }
                if (KIND == 3 || KIND == 5) { f32x4 a0, a1; unpack8(*(const u32x4*)(t + off + bj * HALF), a0, a1); v0 = v0 + a0; v1 = v1 + a1; }
                if (KIND == 5) { v0 = v0 * osc; v1 = v1 * osc; }
                if (KIND == 4 || KIND == 5) { int p0 = 0, p1 = 0; p0 = __builtin_amdgcn_cvt_pk_fp8_f32(v0[0], v0[1], p0, false); p0 = __builtin_amdgcn_cvt_pk_fp8_f32(v0[2], v0[3], p0, true); p1 = __builtin_amdgcn_cvt_pk_fp8_f32(v1[0], v1[1], p1, false); p1 = __builtin_amdgcn_cvt_pk_fp8_f32(v1[2], v1[3], p1, true);
                    *(u32x2*)((unsigned char*)O + off + bj * HALF) = (u32x2){(unsigned)p0, (unsigned)p1}; }
                else *(u32x4*)(O + off + bj * HALF) = pack8(v0, v1); } }
    }
};
struct EpiSlab {
    float* slab; int ldc; size_t slab_stride;
    __device__ __forceinline__ void operator()(const f32x4 (&acc)[2][2][4][2], const GUnit& u, int wr, int wc, int fr, int fq) const {
        const int row0 = u.pm * BM + wr * 64 + fr, col0 = u.pn * BM + wc * 32 + 8 * fq; float* base = slab + (size_t)u.ks * slab_stride;
#pragma unroll
        EPI_LOOP_ROWS { float* rowp = base + (size_t)(row0 + ai * HALF + m * 16) * ldc + col0;
#pragma unroll
            for (int bj = 0; bj < 2; ++bj) { *(f32x4*)(rowp + bj * HALF) = acc[ai][bj][m][0]; *(f32x4*)(rowp + bj * HALF + 4) = acc[ai][bj][m][1]; } }
    }
};
template <bool BASE_BF16> struct EpiRes {
    const float* base32; const bf16* base16; bf16* xb; float* ss; float sc = 1.0f;
    __device__ __forceinline__ void operator()(const f32x4 (&acc)[2][2][4][2], const GUnit& u, int wr, int wc, int fr, int fq) const {
        const int row0 = u.pm * BM + wr * 64 + fr, col0 = u.pn * BM + wc * 32 + 8 * fq;
#pragma unroll
        EPI_LOOP_ROWS { const int row = row0 + ai * HALF + m * 16; const size_t off = (size_t)row * DM + col0; float sq = 0.f;
#pragma unroll
            for (int bj = 0; bj < 2; ++bj) { f32x4 b0, b1;
                if (BASE_BF16) unpack8(*(const u32x4*)(base16 + off + bj * HALF), b0, b1); else { b0 = *(const f32x4*)(base32 + off + bj * HALF); b1 = *(const f32x4*)(base32 + off + bj * HALF + 4); }
                const f32x4 v0 = acc[ai][bj][m][0] * sc + b0, v1 = acc[ai][bj][m][1] * sc + b1;
                *(u32x4*)(xb + off + bj * HALF) = pack8(v0, v1);
                sq += (v0[0] * v0[0] + v0[1] * v0[1]) + (v0[2] * v0[2] + v0[3] * v0[3]) + (v1[0] * v1[0] + v1[1] * v1[1]) + (v1[2] * v1[2] + v1[3] * v1[3]); }
            sq += __shfl_xor(sq, 16); sq += __shfl_xor(sq, 32);
            if (fq == 0) unsafeAtomicAdd(ss + row, sq); }
    }
};
}

struct Params {
    const float *x, *mem, *norm_mix, *norm_mem_q, *norm_mem_kv, *norm_ffn, *norm_final, *w_in, *pool_group_w, *pool_scale, *w_branch_sb, *w_branch_pool, *w_out,
                *xa_w_q, *xa_w_kv, *xa_w_o, *peer_w_query, *peer_sub_keys, *peer_down, *peer_up;
    float* out; unsigned char* ws;
};

__device__ __forceinline__ void p0_transpose_item(const float* W, int N, bf16* WT, int ldt, const float* gk, const float* sn, LAS float* scr, int item, int lane) {
    const int nblk = N / 64, kb = item / nblk, nb = item % nblk, k0 = 64 * kb, n0 = 64 * nb;
    { float t_[64];
#pragma unroll
      for (int kk = 0; kk < 64; ++kk) t_[kk] = W[(size_t)(k0 + kk) * N + n0 + lane];
#pragma unroll
      for (int kk = 0; kk < 64; ++kk) scr[kk * 65 + lane] = t_[kk]; }
    LDS_WAIT(); asm volatile("" ::: "memory");
    const int c = lane & 7;
    float g[8];
#pragma unroll
    for (int j = 0; j < 8; ++j) g[j] = gk ? gk[k0 + 8 * c + j] : 1.f;
#pragma unroll
    for (int jj = 0; jj < 8; ++jj) { const int n = (lane >> 3) + 8 * jj; const LAS float* s = scr + (8 * c) * 65 + n; const float sc = sn ? sn[n0 + n] : 1.f;
        u32x4 o; o.x = cvt_pk_bf16(s[0 * 65] * g[0] * sc, s[1 * 65] * g[1] * sc); o.y = cvt_pk_bf16(s[2 * 65] * g[2] * sc, s[3 * 65] * g[3] * sc);
        o.z = cvt_pk_bf16(s[4 * 65] * g[4] * sc, s[5 * 65] * g[5] * sc); o.w = cvt_pk_bf16(s[6 * 65] * g[6] * sc, s[7 * 65] * g[7] * sc);
        *(u32x4*)(WT + (size_t)(n0 + n) * ldt + k0 + 8 * c) = o; }
    LDS_WAIT(); asm volatile("" ::: "memory");
}
__device__ __forceinline__ void p0_transpose_item_f8(const float* W, int N, unsigned char* WT, int ldt, float scl, LAS float* scr, int item, int lane) {
    const int nblk = N / 64, kb = item / nblk, nb = item % nblk, k0 = 64 * kb, n0 = 64 * nb;
    { float t_[64];
#pragma unroll
      for (int kk = 0; kk < 64; ++kk) t_[kk] = W[(size_t)(k0 + kk) * N + n0 + lane];
#pragma unroll
      for (int kk = 0; kk < 64; ++kk) scr[kk * 65 + lane] = t_[kk]; }
    LDS_WAIT(); asm volatile("" ::: "memory");
    const int c = lane & 3;
#pragma unroll
    for (int jj = 0; jj < 4; ++jj) { const int n = (lane >> 2) + 16 * jj; const LAS float* sp = scr + (16 * c) * 65 + n; u32x4 o;
#pragma unroll
        for (int q = 0; q < 4; ++q) { int pk = 0; pk = __builtin_amdgcn_cvt_pk_fp8_f32(sp[(4 * q) * 65] * scl, sp[(4 * q + 1) * 65] * scl, pk, false); pk = __builtin_amdgcn_cvt_pk_fp8_f32(sp[(4 * q + 2) * 65] * scl, sp[(4 * q + 3) * 65] * scl, pk, true); o[q] = (unsigned)pk; }
        *(u32x4*)(WT + (size_t)(n0 + n) * ldt + k0 + 16 * c) = o; }
    LDS_WAIT(); asm volatile("" ::: "memory");
}
__device__ __forceinline__ void p0_tile128_load(const float* W, int N, int k0, int n0, LAS float* scr, int lane) {
    const int r2 = lane >> 5, cc = lane & 31;
    { float t_[64];
#pragma unroll
      for (int kk = 0; kk < 64; ++kk) t_[kk] = W[(size_t)(k0 + 2 * kk + r2) * N + n0 + cc];
#pragma unroll
      for (int kk = 0; kk < 64; ++kk) scr[(2 * kk + r2) * 33 + cc] = t_[kk]; }
    LDS_WAIT(); asm volatile("" ::: "memory");
}
__device__ __forceinline__ void p0_transpose_item128(const float* W, int N, bf16* WT, int ldt, const float* gk, const float* sn, LAS float* scr, int item, int lane) {
    const int nblk = N / 32, kb = item / nblk, nb = item % nblk, k0 = 128 * kb, n0 = 32 * nb;
    p0_tile128_load(W, N, k0, n0, scr, lane);
    const int c = lane >> 2;
    float g[8];
#pragma unroll
    for (int j = 0; j < 8; ++j) g[j] = gk ? gk[k0 + 8 * c + j] : 1.f;
#pragma unroll
    for (int jj = 0; jj < 8; ++jj) { const int n = (lane & 3) + 4 * jj; const LAS float* s = scr + (8 * c) * 33 + n; const float sc = sn ? sn[n0 + n] : 1.f;
        u32x4 o; o.x = cvt_pk_bf16(s[0 * 33] * g[0] * sc, s[1 * 33] * g[1] * sc); o.y = cvt_pk_bf16(s[2 * 33] * g[2] * sc, s[3 * 33] * g[3] * sc);
        o.z = cvt_pk_bf16(s[4 * 33] * g[4] * sc, s[5 * 33] * g[5] * sc); o.w = cvt_pk_bf16(s[6 * 33] * g[6] * sc, s[7 * 33] * g[7] * sc);
        *(u32x4*)(WT + (size_t)(n0 + n) * ldt + k0 + 8 * c) = o; }
    LDS_WAIT(); asm volatile("" ::: "memory");
}
__device__ __forceinline__ void p0_transpose_item128_f8(const float* W, int N, unsigned char* WT, int ldt, float scl, LAS float* scr, int item, int lane) {
    const int nblk = N / 32, kb = item / nblk, nb = item % nblk, k0 = 128 * kb, n0 = 32 * nb;
    p0_tile128_load(W, N, k0, n0, scr, lane);
    const int c = lane >> 3;
#pragma unroll
    for (int jj = 0; jj < 4; ++jj) { const int n = (lane & 7) + 8 * jj; const LAS float* sp = scr + (16 * c) * 33 + n; u32x4 o;
#pragma unroll
        for (int q = 0; q < 4; ++q) { int pk = 0; pk = __builtin_amdgcn_cvt_pk_fp8_f32(sp[(4 * q) * 33] * scl, sp[(4 * q + 1) * 33] * scl, pk, false); pk = __builtin_amdgcn_cvt_pk_fp8_f32(sp[(4 * q + 2) * 33] * scl, sp[(4 * q + 3) * 33] * scl, pk, true); o[q] = (unsigned)pk; }
        *(u32x4*)(WT + (size_t)(n0 + n) * ldt + k0 + 16 * c) = o; }
    LDS_WAIT(); asm volatile("" ::: "memory");
}
__device__ __forceinline__ void rms_row_to_fp8(const float* xrow, const float* gain, unsigned char* orow, int lane) {
    f32x4 v[4][4]; float sq = 0.f;
#pragma unroll
    for (int i = 0; i < 4; ++i)
#pragma unroll
        for (int k = 0; k < 4; ++k) { v[i][k] = *(const f32x4*)(xrow + i * 1024 + lane * 16 + k * 4); sq += (v[i][k].x * v[i][k].x + v[i][k].y * v[i][k].y) + (v[i][k].z * v[i][k].z + v[i][k].w * v[i][k].w); }
    const float rs = __builtin_amdgcn_rsqf(wave_sum(sq) * (1.0f / DM) + EPS);
#pragma unroll
    for (int i = 0; i < 4; ++i) { u32x4 w;
#pragma unroll
        for (int k = 0; k < 4; ++k) { const f32x4 g = *(const f32x4*)(gain + i * 1024 + lane * 16 + k * 4); int p = 0;
            p = __builtin_amdgcn_cvt_pk_fp8_f32(v[i][k].x * rs * g.x, v[i][k].y * rs * g.y, p, false); p = __builtin_amdgcn_cvt_pk_fp8_f32(v[i][k].z * rs * g.z, v[i][k].w * rs * g.w, p, true); w[k] = (unsigned)p; }
        *(u32x4*)(orow + i * 1024 + lane * 16) = w; }
}
__device__ __forceinline__ void rms_row_to_bf16(const float* xrow, const float* gain, bf16* orow, int lane) {
    const f32x4* xr = (const f32x4*)xrow + lane; f32x4 v[16]; float s = 0.f;
#pragma unroll
    for (int j = 0; j < 16; ++j) { v[j] = xr[64 * j]; s += (v[j].x * v[j].x + v[j].y * v[j].y) + (v[j].z * v[j].z + v[j].w * v[j].w); }
    const float rs = __builtin_amdgcn_rsqf(wave_sum(s) * (1.0f / DM) + EPS);
    u32x2* o8 = (u32x2*)orow + lane; const f32x4* gr = (const f32x4*)gain + lane;
#pragma unroll
    for (int j = 0; j < 16; ++j) { const f32x4 gg = gr[64 * j]; u32x2 w; w.x = cvt_pk_bf16(v[j].x * rs * gg.x, v[j].y * rs * gg.y); w.y = cvt_pk_bf16(v[j].z * rs * gg.z, v[j].w * rs * gg.w); o8[64 * j] = w; }
}
__device__ __forceinline__ void p0_quant_load(const float* src, f32x4 (&v)[4][4], int lane) {
#pragma unroll
    for (int i = 0; i < 4; ++i)
#pragma unroll
        for (int k = 0; k < 4; ++k) v[i][k] = *(const f32x4*)(src + i * 1024 + lane * 16 + k * 4);
}
__device__ __forceinline__ void p0_quant_store(const f32x4 (&v)[4][4], unsigned char* dst4, unsigned char* dst6, float* amax_out, int lane, unsigned char* dst2 = nullptr, float* s2_out = nullptr, unsigned char* dst1 = nullptr, float* s1_out = nullptr) {
    float am = 0.f;
#pragma unroll
    for (int i = 0; i < 4; ++i)
#pragma unroll
        for (int k = 0; k < 4; ++k) am = __builtin_fmaxf(am, __builtin_fmaxf(__builtin_fmaxf(__builtin_fabsf(v[i][k].x), __builtin_fabsf(v[i][k].y)), __builtin_fmaxf(__builtin_fabsf(v[i][k].z), __builtin_fabsf(v[i][k].w))));
    am = wave_max_x(am, lane);
    if (lane == 0) *amax_out = am;
    { const float inv = am > 0.f ? 7.5f / am : 0.f; u32x6 g[2];
#pragma unroll
      for (int h = 0; h < 2; ++h) { f32x16 a, b;
#pragma unroll
          for (int e = 0; e < 16; ++e) { const int i = 2 * h + (e >> 3), t0 = 2 * (e & 7), t1 = t0 + 1;
              a[e] = v[i][t0 >> 2][t0 & 3] * inv; b[e] = v[i][t1 >> 2][t1 & 3] * inv; }
          g[h] = __builtin_amdgcn_cvt_scalef32_2xpk16_fp6_f32(a, b, 1.0f); }
      *(u32x4*)(dst6 + lane * 16) = (u32x4){g[0][0], g[0][1], g[0][2], g[0][3]};
      *(u32x4*)(dst6 + 1024 + lane * 16) = (u32x4){g[0][4], g[0][5], g[1][0], g[1][1]};
      *(u32x4*)(dst6 + 2048 + lane * 16) = (u32x4){g[1][2], g[1][3], g[1][4], g[1][5]}; }
    { const float inv = am > 0.f ? 6.0f / am : 0.f;
#pragma unroll
      for (int c = 0; c < 2; ++c) { u32x4 w;
#pragma unroll
          for (int d = 0; d < 4; ++d) { unsigned pk = 0;
              const f32x4 q0 = v[2 * c + (d >> 1)][2 * (d & 1)] * inv, q1 = v[2 * c + (d >> 1)][2 * (d & 1) + 1] * inv;
              pk = __builtin_amdgcn_cvt_scalef32_pk_fp4_f32(pk, q0.x, q0.y, 1.0f, 0); pk = __builtin_amdgcn_cvt_scalef32_pk_fp4_f32(pk, q0.z, q0.w, 1.0f, 1);
              pk = __builtin_amdgcn_cvt_scalef32_pk_fp4_f32(pk, q1.x, q1.y, 1.0f, 2); pk = __builtin_amdgcn_cvt_scalef32_pk_fp4_f32(pk, q1.z, q1.w, 1.0f, 3); w[d] = pk; }
          *(u32x4*)(dst4 + 1024 * c + lane * 16) = w; } }
    if (dst2) {
        float sq = 0.f;
#pragma unroll
        for (int i = 0; i < 4; ++i)
#pragma unroll
            for (int k = 0; k < 4; ++k) sq += (v[i][k].x * v[i][k].x + v[i][k].y * v[i][k].y) + (v[i][k].z * v[i][k].z + v[i][k].w * v[i][k].w);
        sq = wave_sum_x(sq, lane);
        const float s2 = 0.98f * __builtin_sqrtf(sq * (1.0f / DM)); if (lane == 0) *s2_out = s2;
        u32x4 q;
#pragma unroll
        for (int D = 0; D < 4; ++D) { unsigned im[2];
#pragma unroll
            for (int h = 0; h < 2; ++h) { unsigned pk = 0; f32x4 q0 = v[D][2 * h], q1 = v[D][2 * h + 1];
#pragma unroll
                for (int c = 0; c < 4; ++c) { q0[c] = __builtin_copysignf(__builtin_fabsf(q0[c]) > s2 ? 1.5f : 0.5f, q0[c]); q1[c] = __builtin_copysignf(__builtin_fabsf(q1[c]) > s2 ? 1.5f : 0.5f, q1[c]); }
                pk = __builtin_amdgcn_cvt_scalef32_pk_fp4_f32(pk, q0.x, q0.y, 1.0f, 0); pk = __builtin_amdgcn_cvt_scalef32_pk_fp4_f32(pk, q0.z, q0.w, 1.0f, 1);
                pk = __builtin_amdgcn_cvt_scalef32_pk_fp4_f32(pk, q1.x, q1.y, 1.0f, 2); pk = __builtin_amdgcn_cvt_scalef32_pk_fp4_f32(pk, q1.z, q1.w, 1.0f, 3); im[h] = pk; }
            q[D] = ((im[0] >> 2) & 0x22222222u) | ((im[0] >> 1) & 0x11111111u) | (im[1] & 0x88888888u) | ((im[1] << 1) & 0x44444444u); }
        *(u32x4*)(dst2 + lane * 16) = q; }
    if (dst1) {
        float sa = 0.f;
#pragma unroll
        for (int i = 0; i < 4; ++i)
#pragma unroll
            for (int k = 0; k < 4; ++k) sa += (__builtin_fabsf(v[i][k].x) + __builtin_fabsf(v[i][k].y)) + (__builtin_fabsf(v[i][k].z) + __builtin_fabsf(v[i][k].w));
        sa = wave_sum_x(sa, lane);
        if (lane == 0) *s1_out = sa * (1.0f / DM);
        unsigned b[2] = {0u, 0u};
#pragma unroll
        for (int D = 0; D < 4; ++D)
#pragma unroll
            for (int h = 0; h < 2; ++h) { unsigned pk = 0; const f32x4 q0 = v[D][2 * h], q1 = v[D][2 * h + 1];
                pk = __builtin_amdgcn_cvt_scalef32_pk_fp4_f32(pk, __builtin_copysignf(1.0f, q0.x), __builtin_copysignf(1.0f, q0.y), 1.0f, 0); pk = __builtin_amdgcn_cvt_scalef32_pk_fp4_f32(pk, __builtin_copysignf(1.0f, q0.z), __builtin_copysignf(1.0f, q0.w), 1.0f, 1);
                pk = __builtin_amdgcn_cvt_scalef32_pk_fp4_f32(pk, __builtin_copysignf(1.0f, q1.x), __builtin_copysignf(1.0f, q1.y), 1.0f, 2); pk = __builtin_amdgcn_cvt_scalef32_pk_fp4_f32(pk, __builtin_copysignf(1.0f, q1.z), __builtin_copysignf(1.0f, q1.w), 1.0f, 3);
                unsigned x = (pk >> 3) & 0x11111111u; x = (x | (x >> 3)) & 0x03030303u; x = (x | (x >> 6)) & 0x000F000Fu; x = (x | (x >> 12)) & 0xFFu;
                const int B = 2 * D + h; b[B >> 2] |= x << (8 * (B & 3)); }
        *(u32x2*)(dst1 + lane * 8) = (u32x2){b[0], b[1]}; }
}
__device__ __forceinline__ void p0_convert(const float* src, bf16* dst, size_t n, size_t gtid, size_t nthr) {
    const size_t nch = n / 8;
    for (size_t i = gtid; i < nch; i += 4 * nthr) {
        f32x4 a[4][2];
#pragma unroll
        for (int u = 0; u < 4; ++u) { const size_t c = i + u * nthr; if (c < nch) { a[u][0] = *(const f32x4*)(src + c * 8); a[u][1] = *(const f32x4*)(src + c * 8 + 4); } }
#pragma unroll
        for (int u = 0; u < 4; ++u) { const size_t c = i + u * nthr; if (c < nch) *(u32x4*)(dst + c * 8) = pg8::pack8(a[u][0], a[u][1]); }
    }
}

typedef float f32x16v __attribute__((ext_vector_type(16)));
__device__ __forceinline__ f32x16 mfma32(const bf16x8 a, const bf16x8 b, const f32x16 c) { return __builtin_amdgcn_mfma_f32_32x32x16_bf16(a, b, c, 0, 0, 0); }
__device__ __forceinline__ f32x16 zero16() { f32x16 z;
#pragma unroll
    for (int i = 0; i < 16; ++i) { float e; asm volatile("v_mov_b32 %0, 0" : "=v"(e)); z[i] = e; }
    return z; }
__device__ __forceinline__ void mfma_done(const f32x16& a) { const float d = a[0] + a[15]; asm volatile("s_nop 7" :: "v"(d) : "memory"); }
__device__ __forceinline__ void mfma_done4(const f32x16& a, const f32x16& b, const f32x16& c, const f32x16& e) { const float d = (a[0] + b[0]) + (c[0] + e[0]); asm volatile("s_nop 7" :: "v"(d) : "memory"); }
constexpr float SB_EXIT = 30.0f;
constexpr float ATTN_SC = 8.0f, MIXED_SC = 16.0f, WBR_SC = 64.0f, GATED_SC = 16.0f;
__device__ __forceinline__ void sb_attn_item(const bf16* qb, const bf16* kb, const bf16* vT, bf16* attn, int h, int qt, int lane) {
    const int r = lane & 31, hh = lane >> 5, t0 = qt * 32;
    const float scale = 0.08838834764831845f;
    const bf16* qbase_p = qb + (size_t)t0 * SBW + h * HD;
    const unsigned voffKQ = (unsigned)(r * SBW + 8 * hh) * 2u, voffV = (unsigned)(r * SEQ + 4 * hh) * 2u;
    f32x16 o[4];
#pragma unroll
    for (int nb = 0; nb < 4; ++nb) o[nb] = zero16();
    float carry = 0.f;
    bf16x8 qf[8];
#pragma unroll
    for (int st = 0; st < 8; ++st) qf[st] = __builtin_bit_cast(bf16x8, ld16(qbase_p, voffKQ, 32 * st));
    for (int jb = 0; ; ++jb) {
        const int kbase = t0 - 32 * jb; if (kbase < 0) break;
        bf16x8 kf[8]; u32x4 vf0[4], vf1[4];
        const bf16* kbase_p = kb + (size_t)kbase * SBW + h * HD;
#pragma unroll
        for (int st = 0; st < 8; ++st) kf[st] = __builtin_bit_cast(bf16x8, ld16(kbase_p, voffKQ, 32 * st));
#pragma unroll
        for (int nb = 0; nb < 4; ++nb) { const bf16* vb = vT + (size_t)(h * HD + nb * 32) * SEQ + kbase;
            const u32x2 lo = ld8(vb, voffV, 0), hi = ld8(vb, voffV, 16); vf0[nb].x = lo.x; vf0[nb].y = lo.y; vf0[nb].z = hi.x; vf0[nb].w = hi.y; }
        asm volatile("s_waitcnt vmcnt(0)\n\ts_nop 7" ::: "memory");
        f32x16 s = zero16();
#pragma unroll
        for (int st = 0; st < 8; ++st) s = mfma32(kf[st], qf[st], s);
        mfma_done(s);
#pragma unroll
        for (int nb = 0; nb < 4; ++nb) { const bf16* vb = vT + (size_t)(h * HD + nb * 32) * SEQ + kbase;
            const u32x2 lo = ld8(vb, voffV, 32), hi = ld8(vb, voffV, 48); vf1[nb].x = lo.x; vf1[nb].y = lo.y; vf1[nb].z = hi.x; vf1[nb].w = hi.y; }
        float z[16], sp[16];
#pragma unroll
        for (int i = 0; i < 16; ++i) { z[i] = s[i] * scale; const int koff = 8 * (i >> 2) + 4 * hh + (i & 3);
            const bool valid = (jb > 0) || (koff < r);
            const float az = __builtin_fabsf(z[i]);
            const float v = __builtin_fmaxf(z[i], 0.f) + LN2 * flog2(1.0f + fexp2(-az * LOG2E));
            sp[i] = valid ? v : 0.f; }
        float G[4], P[4];
#pragma unroll
        for (int g = 0; g < 4; ++g) { G[g] = (sp[4 * g] + sp[4 * g + 1]) + (sp[4 * g + 2] + sp[4 * g + 3]); P[g] = xchg32(G[g], hh); }
        float after = carry;
        unsigned pk[8];
#pragma unroll
        for (int g = 3; g >= 0; --g) {
            const float base = after + (hh == 0 ? P[g] : 0.f);
            float c3 = base + sp[4 * g + 3], c2 = c3 + sp[4 * g + 2], c1 = c2 + sp[4 * g + 1], c0 = c1 + sp[4 * g];
            float a0 = fexp2((z[4 * g] - c0) * LOG2E), a1 = fexp2((z[4 * g + 1] - c1) * LOG2E), a2 = fexp2((z[4 * g + 2] - c2) * LOG2E), a3 = fexp2((z[4 * g + 3] - c3) * LOG2E);
            if (jb == 0) { const int k0 = 8 * g + 4 * hh; a0 = (k0 < r) ? a0 : 0.f; a1 = (k0 + 1 < r) ? a1 : 0.f; a2 = (k0 + 2 < r) ? a2 : 0.f; a3 = (k0 + 3 < r) ? a3 : 0.f; }
            pk[2 * g] = cvt_pk_bf16(a0, a1); pk[2 * g + 1] = cvt_pk_bf16(a2, a3);
            after += G[g] + P[g];
        }
        carry = after;
        asm volatile("s_waitcnt vmcnt(0)\n\ts_nop 7" ::: "memory");
        { bf16x8 pf; { u32x4 w; w.x = pk[0]; w.y = pk[1]; w.z = pk[2]; w.w = pk[3]; pf = __builtin_bit_cast(bf16x8, w); }
#pragma unroll
          for (int nb = 0; nb < 4; ++nb) o[nb] = mfma32(__builtin_bit_cast(bf16x8, vf0[nb]), pf, o[nb]); }
        { bf16x8 pf; { u32x4 w; w.x = pk[4]; w.y = pk[5]; w.z = pk[6]; w.w = pk[7]; pf = __builtin_bit_cast(bf16x8, w); }
#pragma unroll
          for (int nb = 0; nb < 4; ++nb) o[nb] = mfma32(__builtin_bit_cast(bf16x8, vf1[nb]), pf, o[nb]); }
        mfma_done4(o[0], o[1], o[2], o[3]);
        if (__all(carry > SB_EXIT)) break;
    }
    bf16* orow = attn + (size_t)(t0 + r) * SBW + h * HD + 4 * hh;
#pragma unroll
    for (int nb = 0; nb < 4; ++nb)
#pragma unroll
        for (int g = 0; g < 4; ++g) { u32x2 w; w.x = cvt_pk_bf16(o[nb][4 * g], o[nb][4 * g + 1]); w.y = cvt_pk_bf16(o[nb][4 * g + 2], o[nb][4 * g + 3]);
            *(u32x2*)(orow + nb * 32 + 8 * g) = w; }
}

constexpr int XK_STRIDE = 272, XV_STRIDE = 520, XV_OFF = MEML * XK_STRIDE;
__device__ __forceinline__ void xattn_item(const float* xqs, const float* ss2, LAS const unsigned char* ldsK, LAS const unsigned char* ldsV, bf16* ob, int h, int tt, int lane) {
    const int r = lane & 31, hh = lane >> 5, t0 = tt * 32, tok = t0 + r;
    const float qs = __builtin_amdgcn_rsqf(ss2[tok] * (1.0f / DM) + EPS) * 0.08838834764831845f;
    bf16x8 qf[8];
#pragma unroll
    for (int s = 0; s < 8; ++s) { f32x4 a0 = (f32x4){0.f, 0.f, 0.f, 0.f}, a1 = a0;
#pragma unroll
        for (int ks = 0; ks < 4; ++ks) { const float* p = xqs + (size_t)ks * SEQ * XAW + (size_t)tok * XAW + h * HD + 16 * s + 8 * hh; a0 = a0 + *(const f32x4*)p; a1 = a1 + *(const f32x4*)(p + 4); }
        qf[s] = __builtin_bit_cast(bf16x8, pg8::pack8(a0 * qs, a1 * qs)); }
    float mx = -3.0e38f;
#pragma unroll 1
    for (int kbk = 0; kbk < 8; ++kbk) {
        f32x16 sc = zero16();
        LAS const unsigned char* krow = ldsK + (kbk * 32 + r) * XK_STRIDE + 16 * hh;
#pragma unroll
        for (int hf = 0; hf < 2; ++hf) {
            bf16x8 kf[4];
#pragma unroll
            for (int st = 0; st < 4; ++st) kf[st] = *(LAS const bf16x8*)(krow + 32 * (4 * hf + st));
            asm volatile("s_waitcnt lgkmcnt(0)\n\ts_nop 3" ::: "memory");
#pragma unroll
            for (int st = 0; st < 4; ++st) sc = mfma32(kf[st], qf[4 * hf + st], sc);
            mfma_done(sc); }
#pragma unroll
        for (int i = 0; i < 16; ++i) mx = __builtin_fmaxf(mx, sc[i]);
    }
    mx = __builtin_fmaxf(mx, xchg32(mx, hh));
    float sum = 0.f;
    f32x16 o[4];
#pragma unroll
    for (int nb = 0; nb < 4; ++nb) o[nb] = zero16();
#pragma unroll 1
    for (int kbk = 0; kbk < 8; ++kbk) {
        f32x16 sc = zero16();
        LAS const unsigned char* krow = ldsK + (kbk * 32 + r) * XK_STRIDE + 16 * hh;
#pragma unroll
        for (int hf = 0; hf < 2; ++hf) {
            bf16x8 kf[4];
#pragma unroll
            for (int st = 0; st < 4; ++st) kf[st] = *(LAS const bf16x8*)(krow + 32 * (4 * hf + st));
            asm volatile("s_waitcnt lgkmcnt(0)\n\ts_nop 3" ::: "memory");
#pragma unroll
            for (int st = 0; st < 4; ++st) sc = mfma32(kf[st], qf[4 * hf + st], sc);
            mfma_done(sc); }
        unsigned pk[8];
#pragma unroll
        for (int i = 0; i < 16; i += 2) { const float e0 = fexp2((sc[i] - mx) * LOG2E), e1 = fexp2((sc[i + 1] - mx) * LOG2E); sum += e0 + e1; pk[i >> 1] = cvt_pk_bf16(e0, e1); }
#pragma unroll
        for (int s2 = 0; s2 < 2; ++s2) {
            bf16x8 pf; { u32x4 w; w.x = pk[4 * s2]; w.y = pk[4 * s2 + 1]; w.z = pk[4 * s2 + 2]; w.w = pk[4 * s2 + 3]; pf = __builtin_bit_cast(bf16x8, w); }
            u32x4 vf[4];
#pragma unroll
            for (int nb = 0; nb < 4; ++nb) {
                LAS const unsigned char* vrow = ldsV + (nb * 32 + r) * XV_STRIDE + (kbk * 32 + 16 * s2 + 4 * hh) * 2;
                const u32x2 lo = *(LAS const u32x2*)vrow, hi = *(LAS const u32x2*)(vrow + 16);
                vf[nb].x = lo.x; vf[nb].y = lo.y; vf[nb].z = hi.x; vf[nb].w = hi.y; }
            asm volatile("s_waitcnt lgkmcnt(0)\n\ts_nop 3" ::: "memory");
#pragma unroll
            for (int nb = 0; nb < 4; ++nb) o[nb] = mfma32(__builtin_bit_cast(bf16x8, vf[nb]), pf, o[nb]);
            mfma_done4(o[0], o[1], o[2], o[3]);
        }
    }
    sum += xchg32(sum, hh);
    const float inv = frcp(sum);
    bf16* orow = ob + (size_t)tok * XAW + h * HD + 4 * hh;
#pragma unroll
    for (int nb = 0; nb < 4; ++nb)
#pragma unroll
        for (int g = 0; g < 4; ++g) { u32x2 w; w.x = cvt_pk_bf16(o[nb][4 * g] * inv, o[nb][4 * g + 1] * inv); w.y = cvt_pk_bf16(o[nb][4 * g + 2] * inv, o[nb][4 * g + 3] * inv); *(u32x2*)(orow + nb * 32 + 8 * g) = w; }
}

template <int N> __device__ __forceinline__ void bitonic_sort_desc(float (&a)[N]) {
#pragma unroll
    for (int k = 2; k <= N; k <<= 1)
#pragma unroll
        for (int j = k >> 1; j > 0; j >>= 1)
#pragma unroll
            for (int i = 0; i < N; ++i) { const int l = i ^ j; if (l > i) { const bool desc = ((i & k) == 0); const float lo = __builtin_fminf(a[i], a[l]), hi = __builtin_fmaxf(a[i], a[l]); a[i] = desc ? hi : lo; a[l] = desc ? lo : hi; } }
}
__device__ __forceinline__ void merge_top16(float (&a)[16], const float (&b)[16]) {
#pragma unroll
    for (int i = 0; i < 16; ++i) a[i] = __builtin_fmaxf(a[i], b[15 - i]);
#pragma unroll
    for (int j = 8; j > 0; j >>= 1)
#pragma unroll
        for (int i = 0; i < 16; ++i) { const int l = i ^ j; if (l > i) { const float lo = __builtin_fminf(a[i], a[l]), hi = __builtin_fmaxf(a[i], a[l]); a[i] = hi; a[l] = lo; } }
}
__device__ __forceinline__ void top16_of_64(const float (&v)[64], float (&out)[16]) {
    float g0[16], g1[16], g2[16], g3[16];
#pragma unroll
    for (int i = 0; i < 16; ++i) { g0[i] = v[i]; g1[i] = v[16 + i]; g2[i] = v[32 + i]; g3[i] = v[48 + i]; }
    bitonic_sort_desc<16>(g0); bitonic_sort_desc<16>(g1); bitonic_sort_desc<16>(g2); bitonic_sort_desc<16>(g3);
    merge_top16(g0, g1); merge_top16(g2, g3); merge_top16(g0, g2);
#pragma unroll
    for (int i = 0; i < 16; ++i) out[i] = g0[i];
}
__device__ __forceinline__ float pack_tag(float v, unsigned tag, unsigned mask) { return __builtin_bit_cast(float, (__builtin_bit_cast(unsigned, v) & ~mask) | tag); }
__device__ __forceinline__ void route_item(const bf16* pq, const bf16* keys, int* eid, float* gate, int h, int tt, int lane) {
    const int r = lane & 31, hh = lane >> 5, tok = tt * 32 + r;
    float top[2][16];
#pragma unroll
    for (int p = 0; p < 2; ++p) {
        bf16x8 qf[8];
        { const bf16* qrow = pq + (size_t)tok * PQW + h * 256 + p * 128 + 8 * hh;
#pragma unroll
          for (int s = 0; s < 8; ++s) qf[s] = *(const bf16x8*)(qrow + 16 * s); }
        asm volatile("s_waitcnt vmcnt(0)" ::: "memory");
        float mine[16], other[16];
#pragma unroll
        for (int kbk = 0; kbk < 4; ++kbk) {
            f32x16 sc = zero16();
            const bf16* krow = keys + (size_t)((h * 2 + p) * PKEYS + kbk * 32 + r) * 128 + 8 * hh;
#pragma unroll
            for (int hf = 0; hf < 2; ++hf) {
                bf16x8 kf[4];
#pragma unroll
                for (int st = 0; st < 4; ++st) kf[st] = *(const bf16x8*)(krow + 16 * (4 * hf + st));
                asm volatile("s_waitcnt vmcnt(0)\n\ts_nop 7" ::: "memory");
#pragma unroll
                for (int st = 0; st < 4; ++st) sc = mfma32(kf[st], qf[4 * hf + st], sc);
                mfma_done(sc); }
            float blk[16];
#pragma unroll
            for (int i = 0; i < 16; ++i) { const unsigned key = (unsigned)(kbk * 32 + 8 * (i >> 2) + (i & 3)) + 4u * (unsigned)hh; blk[i] = pack_tag(sc[i], key, 127u); }
            bitonic_sort_desc<16>(blk);
            if (kbk == 0) {
#pragma unroll
                for (int i = 0; i < 16; ++i) mine[i] = blk[i];
            } else merge_top16(mine, blk);
        }
#pragma unroll
        for (int i = 0; i < 16; ++i) other[i] = xchg32(mine[i], hh);
        merge_top16(mine, other);
#pragma unroll
        for (int i = 0; i < 16; ++i) top[p][i] = mine[i];
    }
    float best[16];
    {
        float cv[64]; int nc = 0;
#pragma unroll
        for (int i = 0; i < 16; ++i)
#pragma unroll
            for (int j = 0; j < 16; ++j) if ((i + 1) * (j + 1) <= 16) { cv[nc] = pack_tag(top[0][i] + top[1][j], (unsigned)(i * 16 + j), 255u); ++nc; }
#pragma unroll
        for (int i = 50; i < 64; ++i) cv[i] = -3.0e38f;
#pragma unroll
        for (int gq = 0; gq < 4; ++gq) { float blk[16];
#pragma unroll
            for (int i = 0; i < 16; ++i) blk[i] = cv[gq * 16 + i];
            bitonic_sort_desc<16>(blk);
            if (gq == 0) {
#pragma unroll
                for (int i = 0; i < 16; ++i) best[i] = blk[i];
            } else merge_top16(best, blk); }
    }
    const float mx = best[0];
    float den = 0.f;
#pragma unroll
    for (int i = 0; i < 16; ++i) den += fexp2((best[i] - mx) * LOG2E);
    const float inv = frcp(den);
    if (hh == 0) {
        int* eo = eid + (size_t)tok * 128 + h * 16; float* go = gate + (size_t)tok * 128 + h * 16;
#pragma unroll
        for (int k = 0; k < 16; ++k) {
            const unsigned tag = __builtin_bit_cast(unsigned, best[k]) & 255u; const int i = (int)(tag >> 4), j = (int)(tag & 15u);
            unsigned k1 = 0u, k2 = 0u;
#pragma unroll
            for (int q = 0; q < 16; ++q) { k1 = (i == q) ? (__builtin_bit_cast(unsigned, top[0][q]) & 127u) : k1; k2 = (j == q) ? (__builtin_bit_cast(unsigned, top[1][q]) & 127u) : k2; }
            eo[k] = (int)(k1 * 128u + k2); go[k] = fexp2((best[k] - mx) * LOG2E) * inv;
        }
    }
}

__device__ __forceinline__ float gelu_erf(float u) { return 0.5f * u * (1.0f + erff(u * 0.70710678118654752f)); }
struct Row6 { u32x4 p0, p1, p2; };
__device__ __forceinline__ f32x32 unpack6(const Row6& r, int h) { const u32x6 g = h ? (u32x6){r.p1.z, r.p1.w, r.p2.x, r.p2.y, r.p2.z, r.p2.w} : (u32x6){r.p0.x, r.p0.y, r.p0.z, r.p0.w, r.p1.x, r.p1.y};
    return __builtin_amdgcn_cvt_scalef32_pk32_f32_fp6(g, 1.0f); }
__device__ __forceinline__ float dot_row4(const Row6& r, const f32x4 (&x)[4][4]) {
    f32x2 d = (f32x2){0.f, 0.f};
#pragma unroll
    for (int c = 0; c < 2; ++c) { const u32x4 w = c ? r.p1 : r.p0;
#pragma unroll
        for (int dw = 0; dw < 4; ++dw) { const f32x4 x0 = x[2 * c + (dw >> 1)][2 * (dw & 1)], x1 = x[2 * c + (dw >> 1)][2 * (dw & 1) + 1];
            d = __builtin_elementwise_fma(__builtin_amdgcn_cvt_scalef32_pk_f32_fp4(w[dw], 1.0f, 0), (f32x2){x0.x, x0.y}, d); d = __builtin_elementwise_fma(__builtin_amdgcn_cvt_scalef32_pk_f32_fp4(w[dw], 1.0f, 1), (f32x2){x0.z, x0.w}, d);
            d = __builtin_elementwise_fma(__builtin_amdgcn_cvt_scalef32_pk_f32_fp4(w[dw], 1.0f, 2), (f32x2){x1.x, x1.y}, d); d = __builtin_elementwise_fma(__builtin_amdgcn_cvt_scalef32_pk_f32_fp4(w[dw], 1.0f, 3), (f32x2){x1.z, x1.w}, d); }
        __builtin_amdgcn_sched_barrier(0); }
    return d.x + d.y;
}
__device__ __forceinline__ void axpy_row4(const Row6& r, const float a, f32x2 (&acc)[4][8]) {
    const f32x2 a2 = (f32x2){a, a};
#pragma unroll
    for (int c = 0; c < 2; ++c) { const u32x4 w = c ? r.p1 : r.p0;
#pragma unroll
        for (int dw = 0; dw < 4; ++dw) { const int ci = 2 * c + (dw >> 1), kb = 4 * (dw & 1);
            acc[ci][kb]     = __builtin_elementwise_fma(__builtin_amdgcn_cvt_scalef32_pk_f32_fp4(w[dw], 1.0f, 0), a2, acc[ci][kb]);
            acc[ci][kb + 1] = __builtin_elementwise_fma(__builtin_amdgcn_cvt_scalef32_pk_f32_fp4(w[dw], 1.0f, 1), a2, acc[ci][kb + 1]);
            acc[ci][kb + 2] = __builtin_elementwise_fma(__builtin_amdgcn_cvt_scalef32_pk_f32_fp4(w[dw], 1.0f, 2), a2, acc[ci][kb + 2]);
            acc[ci][kb + 3] = __builtin_elementwise_fma(__builtin_amdgcn_cvt_scalef32_pk_f32_fp4(w[dw], 1.0f, 3), a2, acc[ci][kb + 3]); }
        __builtin_amdgcn_sched_barrier(0); }
}
#define W6(c_, e_) (16 * (c_) + (e_))
__device__ __forceinline__ float dot_row6(const Row6& r, const f32x4 (&x)[4][4]) {
    f32x2 d = (f32x2){0.f, 0.f};
#pragma unroll
    for (int h = 0; h < 2; ++h) { const f32x32 w = unpack6(r, h);
#pragma unroll
        for (int c = 0; c < 2; ++c)
#pragma unroll
            for (int k = 0; k < 4; ++k) { d = __builtin_elementwise_fma((f32x2){w[W6(c, 4 * k)], w[W6(c, 4 * k + 1)]}, (f32x2){x[2 * h + c][k].x, x[2 * h + c][k].y}, d);
                                          d = __builtin_elementwise_fma((f32x2){w[W6(c, 4 * k + 2)], w[W6(c, 4 * k + 3)]}, (f32x2){x[2 * h + c][k].z, x[2 * h + c][k].w}, d); }
        __builtin_amdgcn_sched_barrier(0); }
    return d.x + d.y;
}
__device__ __forceinline__ void axpy_row6(const Row6& r, const float a, f32x2 (&acc)[4][8]) {
    const f32x2 a2 = (f32x2){a, a};
#pragma unroll
    for (int h = 0; h < 2; ++h) { const f32x32 w = unpack6(r, h);
#pragma unroll
        for (int c = 0; c < 2; ++c)
#pragma unroll
            for (int k = 0; k < 8; ++k) acc[2 * h + c][k] = __builtin_elementwise_fma((f32x2){w[W6(c, 2 * k)], w[W6(c, 2 * k + 1)]}, a2, acc[2 * h + c][k]);
        __builtin_amdgcn_sched_barrier(0); }
}
__device__ __forceinline__ float reduce4(float d0, float d1, float d2, float d3, int lane) {
    const int hh = lane >> 5, q = (lane >> 4) & 1;
    const float r01 = (hh ? d1 : d0) + xchg32(hh ? d0 : d1, hh);
    const float r23 = (hh ? d3 : d2) + xchg32(hh ? d2 : d3, hh);
    const float r = (q ? r23 : r01) + xchg16(q ? r01 : r23, q);
    return row_sum16(r);
}
__device__ __forceinline__ Row6 expand2(const u32x4 q) { Row6 r;
#pragma unroll
    for (int D = 0; D < 4; ++D) { const unsigned w = q[D];
        const unsigned o0 = ((w & 0x22222222u) << 2) | ((w & 0x11111111u) << 1) | 0x11111111u, o1 = (w & 0x88888888u) | ((w & 0x44444444u) >> 1) | 0x11111111u;
        if (D < 2) { r.p0[2 * (D & 1)] = o0; r.p0[2 * (D & 1) + 1] = o1; } else { r.p1[2 * (D & 1)] = o0; r.p1[2 * (D & 1) + 1] = o1; } }
    r.p2 = (u32x4){0u, 0u, 0u, 0u}; return r; }
__device__ __forceinline__ Row6 expand1(const u32x2 q) { Row6 r;
#pragma unroll
    for (int B = 0; B < 8; ++B) { unsigned x = (q[B >> 2] >> (8 * (B & 3))) & 0xFFu; x = (x | (x << 12)) & 0x000F000Fu; x = (x | (x << 6)) & 0x03030303u; x = (x | (x << 3)) & 0x11111111u;
        const unsigned im = (x << 3) | 0x22222222u; if (B < 4) r.p0[B] = im; else r.p1[B - 4] = im; }
    r.p2 = (u32x4){0u, 0u, 0u, 0u}; return r; }
#define RANK16_STEP(n_) { const float o_ = __builtin_bit_cast(float, __builtin_amdgcn_mov_dpp(__builtin_bit_cast(int, v), 0x120 + (n_), 0xf, 0xf, true)); const int oi_ = __builtin_amdgcn_mov_dpp(me, 0x120 + (n_), 0xf, 0xf, true); cnt += ((o_ > v) || (o_ == v && oi_ < me)) ? 1 : 0; }
__device__ __forceinline__ int rank16(const float v, const int lane) {
    const int me = lane & 15; int cnt = 0;
    RANK16_STEP(1) RANK16_STEP(2) RANK16_STEP(3) RANK16_STEP(4) RANK16_STEP(5) RANK16_STEP(6) RANK16_STEP(7) RANK16_STEP(8) RANK16_STEP(9) RANK16_STEP(10) RANK16_STEP(11) RANK16_STEP(12) RANK16_STEP(13) RANK16_STEP(14) RANK16_STEP(15)
    return cnt;
}
#undef RANK16_STEP
__device__ __forceinline__ void peer_token(const bf16* xrow, float ss, const float* g_ffn, const float* g_fin, const unsigned char* down4, const unsigned char* down6, const unsigned char* up4, const unsigned char* up6, const unsigned char* up2, const unsigned char* up1, const float* sdown, const float* sup, const float* sup2, const float* sup1,
                                           const int* eid, const float* gate, float* orow, int lane) {
    const float rs = __builtin_amdgcn_rsqf(ss * (1.0f / DM) + EPS);
    const unsigned lb = (unsigned)lane * 64u;
    const unsigned l8 = (unsigned)lane * 16u;
    f32x4 xn[4][4];
#pragma unroll
    for (int i = 0; i < 4; ++i)
#pragma unroll
        for (int k = 0; k < 4; k += 2) { const int o = i * 4096 + k * 16; f32x4 x0, x1; pg8::unpack8(ld16(xrow, lb >> 1, o >> 1), x0, x1);
            xn[i][k] = x0 * rs * ld16f(g_ffn, lb, o); xn[i][k + 1] = x1 * rs * ld16f(g_ffn, lb, o + 16); }
    const int e_lo = eid[lane], e_hi = eid[64 + lane];
    float w_lo = 0.f, w_hi = 0.f;
    const float fsc = ((lane & 15) < 2) ? (1.0f / 7.5f) : (1.0f / 6.0f);
    constexpr int PEER_NB = 4;
#define PEER_LD6(buf, tab, jj) do { _Pragma("unroll") for (int q_ = 0; q_ < PEER_NB; ++q_) { const int j_ = (jj) + q_; const int e_ = __builtin_amdgcn_readlane((jj) < 64 ? e_lo : e_hi, j_ & 63); const unsigned vo_ = (unsigned)e_ * (unsigned)ROW6 + l8;     \
        buf[q_].p0 = ld16((tab), vo_, 0); buf[q_].p1 = ld16((tab), vo_, 1024); buf[q_].p2 = ld16((tab), vo_, 2048); } } while (0)
#define PEER_LD4(buf, tab, jj) do { _Pragma("unroll") for (int q_ = 0; q_ < PEER_NB; ++q_) { const int j_ = (jj) + q_; const int e_ = __builtin_amdgcn_readlane((jj) < 64 ? e_lo : e_hi, j_ & 63); const unsigned vo_ = (unsigned)e_ * (unsigned)ROW4 + l8; \
        buf[q_].p0 = ld16((tab), vo_, 0); buf[q_].p1 = ld16((tab), vo_, 1024); } } while (0)
#define PEER_LDM(buf, jj) do { _Pragma("unroll") for (int q_ = 0; q_ < 2; ++q_) { const int j_ = (jj) + q_; const int e_ = __builtin_amdgcn_readlane((jj) < 64 ? e_lo : e_hi, j_ & 63); const unsigned vo_ = (unsigned)e_ * (unsigned)ROW6 + l8;     \
        buf[q_].p0 = ld16(down6, vo_, 0); buf[q_].p1 = ld16(down6, vo_, 1024); buf[q_].p2 = ld16(down6, vo_, 2048); } \
      _Pragma("unroll") for (int q_ = 2; q_ < 4; ++q_) { const int j_ = (jj) + q_; const int e_ = __builtin_amdgcn_readlane((jj) < 64 ? e_lo : e_hi, j_ & 63); const unsigned vo_ = (unsigned)e_ * (unsigned)ROW4 + l8; \
        buf[q_].p0 = ld16(down4, vo_, 0); buf[q_].p1 = ld16(down4, vo_, 1024); } } while (0)
#define PEER_PUT4(r_, jb_) do { const float t0_ = __builtin_bit_cast(float, __builtin_amdgcn_readlane(__builtin_bit_cast(int, r_), 0)), t2_ = __builtin_bit_cast(float, __builtin_amdgcn_readlane(__builtin_bit_cast(int, r_), 16)); \
        const float t1_ = __builtin_bit_cast(float, __builtin_amdgcn_readlane(__builtin_bit_cast(int, r_), 32)), t3_ = __builtin_bit_cast(float, __builtin_amdgcn_readlane(__builtin_bit_cast(int, r_), 48)); \
        const int jl_ = (jb_) & 63; const float tv_ = (lane == jl_) ? t0_ : (lane == jl_ + 1) ? t1_ : (lane == jl_ + 2) ? t2_ : t3_; const bool mine_ = (lane >= jl_) && (lane < jl_ + 4); \
        if ((jb_) < 64) w_lo = mine_ ? tv_ : w_lo; else w_hi = mine_ ? tv_ : w_hi; } while (0)
#define PEER_DOT6(buf, jb_) do { const float r_ = reduce4(dot_row6(buf[0], xn), dot_row6(buf[1], xn), dot_row6(buf[2], xn), dot_row6(buf[3], xn), lane); PEER_PUT4(r_, jb_); } while (0)
#define PEER_DOTM(buf, jb_) do { const float r_ = reduce4(dot_row6(buf[0], xn), dot_row6(buf[1], xn), dot_row4(buf[2], xn), dot_row4(buf[3], xn), lane); PEER_PUT4(r_, jb_); } while (0)
#define PEER_DOT4(buf, jb_) do { const float r_ = reduce4(dot_row4(buf[0], xn), dot_row4(buf[1], xn), dot_row4(buf[2], xn), dot_row4(buf[3], xn), lane); PEER_PUT4(r_, jb_); } while (0)
#define PEER_WQ(jj) __builtin_bit_cast(float, __builtin_amdgcn_readlane(__builtin_bit_cast(int, (jj) < 64 ? w_lo : w_hi), (jj) & 63))
    {
        Row6 bA[PEER_NB], bB[PEER_NB], bC[PEER_NB], bD[PEER_NB];
        PEER_LDM(bA, 0); PEER_LD4(bB, down4, 4);
#pragma unroll 1
        for (int j0 = 0; j0 < 128; j0 += 16) {
            PEER_LD4(bC, down4, j0 + 8);
            PEER_DOTM(bA, j0);
            PEER_LD4(bD, down4, j0 + 12);
            PEER_DOT4(bB, j0 + 4);
            if (j0 + 16 < 128) PEER_LDM(bA, j0 + 16);
            PEER_DOT4(bC, j0 + 8);
            if (j0 + 16 < 128) PEER_LD4(bB, down4, j0 + 20);
            PEER_DOT4(bD, j0 + 12);
        }
    }
    int eu_lo, eu_hi;
    { const float a_lo = gate[lane] * gelu_erf(w_lo * sdown[e_lo] * fsc), a_hi = gate[64 + lane] * gelu_erf(w_hi * sdown[e_hi] * fsc);
      const int d_lo = ((lane & ~15) + rank16(__builtin_fabsf(a_lo), lane)) * 4, d_hi = ((lane & ~15) + rank16(__builtin_fabsf(a_hi), lane)) * 4;
      const float pa_lo = __builtin_bit_cast(float, __builtin_amdgcn_ds_permute(d_lo, __builtin_bit_cast(int, a_lo))), pa_hi = __builtin_bit_cast(float, __builtin_amdgcn_ds_permute(d_hi, __builtin_bit_cast(int, a_hi)));
      eu_lo = __builtin_amdgcn_ds_permute(d_lo, e_lo); eu_hi = __builtin_amdgcn_ds_permute(d_hi, e_hi);
      const int pos = lane & 15; const float fscu = (pos < 2) ? (1.0f / 7.5f) : (1.0f / 6.0f);
      w_lo = pa_lo * ((pos < 8) ? sup[eu_lo] * fscu : (pos < 12) ? sup2[eu_lo] : sup1[eu_lo]); w_hi = pa_hi * ((pos < 8) ? sup[eu_hi] * fscu : (pos < 12) ? sup2[eu_hi] : sup1[eu_hi]); }
    f32x2 acc[4][8];
#pragma unroll
    for (int i = 0; i < 4; ++i)
#pragma unroll
        for (int k = 0; k < 8; ++k) acc[i][k] = (f32x2){0.f, 0.f};
    {
#define PEER_LDU6(buf, jj) do { _Pragma("unroll") for (int q_ = 0; q_ < 2; ++q_) { const int j_ = (jj) + q_; const int e_ = __builtin_amdgcn_readlane((jj) < 64 ? eu_lo : eu_hi, j_ & 63); const unsigned vo_ = (unsigned)e_ * (unsigned)ROW6 + l8; \
        buf[q_].p0 = ld16(up6, vo_, 0); buf[q_].p1 = ld16(up6, vo_, 1024); buf[q_].p2 = ld16(up6, vo_, 2048); } } while (0)
#define PEER_LDU4(buf, jj) do { _Pragma("unroll") for (int q_ = 0; q_ < 2; ++q_) { const int j_ = (jj) + q_; const int e_ = __builtin_amdgcn_readlane((jj) < 64 ? eu_lo : eu_hi, j_ & 63); const unsigned vo_ = (unsigned)e_ * (unsigned)ROW4 + l8; \
        buf[q_].p0 = ld16(up4, vo_, 0); buf[q_].p1 = ld16(up4, vo_, 1024); } } while (0)
#define PEER_LDQ(buf, jj) do { _Pragma("unroll") for (int q_ = 0; q_ < 4; ++q_) { const int j_ = (jj) + q_; const int e_ = __builtin_amdgcn_readlane((jj) < 64 ? eu_lo : eu_hi, j_ & 63); buf[q_] = ld16(up2, (unsigned)e_ * (unsigned)ROW2 + l8, 0); } } while (0)
#define PEER_LD1(buf, jj) do { _Pragma("unroll") for (int q_ = 0; q_ < 4; ++q_) { const int j_ = (jj) + q_; const int e_ = __builtin_amdgcn_readlane((jj) < 64 ? eu_lo : eu_hi, j_ & 63); buf[q_] = ld8(up1, (unsigned)e_ * (unsigned)ROW1 + (l8 >> 1), 0); } } while (0)
        Row6 b0[2], c0[2], c1[2], c2[2]; u32x4 dq[4]; u32x2 d1[4];
        asm volatile("" : "+v"(w_lo), "+v"(w_hi) :: "memory");
        PEER_LDU6(b0, 0); PEER_LDU4(c0, 2);
#pragma unroll 1
        for (int j0 = 0; j0 < 128; j0 += 16) {
            PEER_LDU4(c1, j0 + 4); PEER_LDU4(c2, j0 + 6); PEER_LDQ(dq, j0 + 8); PEER_LD1(d1, j0 + 12);
            axpy_row6(b0[0], PEER_WQ(j0), acc); axpy_row6(b0[1], PEER_WQ(j0 + 1), acc);
            if (j0 + 16 < 128) PEER_LDU6(b0, j0 + 16);
            axpy_row4(c0[0], PEER_WQ(j0 + 2), acc); axpy_row4(c0[1], PEER_WQ(j0 + 3), acc);
            if (j0 + 16 < 128) PEER_LDU4(c0, j0 + 18);
            axpy_row4(c1[0], PEER_WQ(j0 + 4), acc); axpy_row4(c1[1], PEER_WQ(j0 + 5), acc);
            axpy_row4(c2[0], PEER_WQ(j0 + 6), acc); axpy_row4(c2[1], PEER_WQ(j0 + 7), acc);
#pragma unroll
            for (int q = 0; q < 4; ++q) axpy_row4(expand2(dq[q]), PEER_WQ(j0 + 8 + q), acc);
#pragma unroll
            for (int q = 0; q < 4; ++q) axpy_row4(expand1(d1[q]), PEER_WQ(j0 + 12 + q), acc);
        }
#undef PEER_LDQ
#undef PEER_LD1
#undef PEER_LDU6
#undef PEER_LDU4
    }
#undef PEER_LD6
#undef PEER_LD4
#undef PEER_PUT4
#undef PEER_DOT6
#undef PEER_DOT4
#undef PEER_DOTM
#undef PEER_LDM
#undef PEER_WQ
    float s = 0.f;
    { unsigned lb2 = lb; asm volatile("" : "+v"(lb2));
#pragma unroll
    for (int i = 0; i < 4; ++i)
#pragma unroll
        for (int k = 0; k < 4; k += 2) { const int o = i * 4096 + k * 16; f32x4 xr[2]; pg8::unpack8(ld16(xrow, lb2 >> 1, o >> 1), xr[0], xr[1]);
#pragma unroll
            for (int kk = 0; kk < 2; ++kk) { const int k2 = k + kk;
            acc[i][2 * k2] = acc[i][2 * k2] + (f32x2){xr[kk].x, xr[kk].y}; acc[i][2 * k2 + 1] = acc[i][2 * k2 + 1] + (f32x2){xr[kk].z, xr[kk].w};
            s += (acc[i][2 * k2].x * acc[i][2 * k2].x + acc[i][2 * k2].y * acc[i][2 * k2].y) + (acc[i][2 * k2 + 1].x * acc[i][2 * k2 + 1].x + acc[i][2 * k2 + 1].y * acc[i][2 * k2 + 1].y); } }
    const float rf = __builtin_amdgcn_rsqf(wave_sum_x(s, lane) * (1.0f / DM) + EPS);
#pragma unroll
    for (int i = 0; i < 4; ++i)
#pragma unroll
        for (int k = 0; k < 4; ++k) { const int o = i * 4096 + k * 16; const f32x4 gf = ld16f(g_fin, lb2, o);
            *(f32x4*)(((char*)orow + lb2) + o) = (f32x4){acc[i][2 * k].x * rf * gf.x, acc[i][2 * k].y * rf * gf.y, acc[i][2 * k + 1].x * rf * gf.z, acc[i][2 * k + 1].y * rf * gf.w}; }
    }
}

template <int W> __device__ __forceinline__ void pool_item(const bf16* ub, bf16* pooled, int t0, int cb, int lane) {
    const unsigned voff = (unsigned)(cb + lane * 8) * 2u;
    f32x4 s0 = (f32x4){0.f, 0.f, 0.f, 0.f}, s1 = s0;
#pragma unroll
    for (int j = 1; j < W; ++j) { const int t = t0 - j; if (t >= 0) { f32x4 a0, a1; pg8::unpack8(ld16(ub + (size_t)t * PLW, voff), a0, a1); s0 = s0 + a0; s1 = s1 + a1; } }
#pragma unroll
    for (int i = 0; i < 16; ++i) { const int t = t0 + i; f32x4 c0, c1; pg8::unpack8(ld16(ub + (size_t)t * PLW, voff), c0, c1);
        s0 = s0 + c0; s1 = s1 + c1;
        const int n = (t + 1) < W ? (t + 1) : W; const float ic = 1.0f / (float)n;
        *(u32x4*)((char*)(pooled + (size_t)t * PLW) + voff) = pg8::pack8(s0 * ic - c0, s1 * ic - c1);
        const int told = t - W + 1; if (told >= 0) { f32x4 a0, a1; pg8::unpack8(ld16(ub + (size_t)told * PLW, voff), a0, a1); s0 = s0 - a0; s1 = s1 - a1; } }
}

__global__ void __launch_bounds__(512, 2) fwd(Params p) {
    extern __shared__ __attribute__((aligned(16))) unsigned char lds_raw[];
    LAS unsigned char* lds = (LAS unsigned char*)lds_raw;
    volatile LAS unsigned* MISC = (volatile LAS unsigned*)(lds + MISC_OFF);
    const int wave = __builtin_amdgcn_readfirstlane((int)threadIdx.x >> 6);
    const int G = gridDim.x, bx = blockIdx.x;
    const int vcu = (G % 8 == 0) ? (bx % 8) * (G / 8) + bx / 8 : bx;
    const int gw = vcu * 8 + wave, NGW = G * 8;
    unsigned char* ws = p.ws;
    unsigned* ctl = (unsigned*)(ws + WS_CTL);
    for (int u = threadIdx.x; u < (LDS_BYTES - LDSCTL_OFF) / 4; u += 512) ((LAS unsigned*)(lds + LDSCTL_OFF))[u] = 0u;
    __syncthreads();
    XcdBarrier bar = xcd_barrier_post(ctl + CW_BAR, MISC + 8, wave);

    unsigned char* Win8 = ws + WS_WIN; unsigned char* h1_8 = ws + WS_H1; bf16* Wsb_t = (bf16*)(ws + WS_WSB); bf16* Wpool_t = (bf16*)(ws + WS_WPOOL); bf16* Wout_t = (bf16*)(ws + WS_WOUT);
    bf16* Wxq_t = (bf16*)(ws + WS_WXQ); bf16* Wkv_t = (bf16*)(ws + WS_WKV); bf16* Wxo_t = (bf16*)(ws + WS_WXO); bf16* Wpq_t = (bf16*)(ws + WS_WPQ);
    bf16* gw_t = (bf16*)(ws + WS_GW); bf16* keys_b = (bf16*)(ws + WS_KEYS); bf16* mem_n = (bf16*)(ws + WS_MEMN);
    bf16* kvk = (bf16*)(ws + WS_KVB); bf16* kvT = (bf16*)(ws + WS_KVB + 512 * 1024);
    unsigned char* down4 = ws + WS_DOWN4; unsigned char* down6 = ws + WS_DOWN6; unsigned char* up4 = ws + WS_UP4; unsigned char* up6 = ws + WS_UP6; float* sdown = (float*)(ws + WS_SDOWN); float* sup = (float*)(ws + WS_SUP); unsigned char* up2 = ws + WS_UP2; float* sup2 = (float*)(ws + WS_SUP2); unsigned char* up1 = ws + WS_UP1; float* sup1 = (float*)(ws + WS_SUP1);
    bf16* attn = (bf16*)(ws + WS_ATTN); bf16* pooled = (bf16*)(ws + WS_POOLED); bf16* xb = (bf16*)(ws + WS_XB);
    bf16* qb = (bf16*)(ws + WS_Q); bf16* kb = (bf16*)(ws + WS_K); bf16* vT = (bf16*)(ws + WS_VT); bf16* ub = (bf16*)(ws + WS_UB); bf16* gsb = (bf16*)(ws + WS_GSB); bf16* gpl = (bf16*)(ws + WS_GPL);
    bf16* mixed = (bf16*)(ws + WS_MIXED); bf16* pqb = (bf16*)(ws + WS_PQ); int* eid = (int*)(ws + WS_EID); float* gate = (float*)(ws + WS_GATE);
    float* xqs = (float*)(ws + WS_XQS); bf16* ob = (bf16*)(ws + WS_O); float* kvs = (float*)(ws + WS_KVS);
    bf16* Tb = (bf16*)(ws + WS_T); bf16* gated = (bf16*)(ws + WS_GATED);
    float* ss2 = (float*)(ws + WS_CTL + CTL_SS2); float* ss3 = (float*)(ws + WS_CTL + CTL_SS3);

    PROBE_BEGIN(0)
    {
        FRESH_IDS();
        LAS float* scr = (LAS float*)(lds + wave * 16896);
        int it = gw;
#define TJOB(W, K_, N_, WT, LDT, GK, SN) { const int n_it = ((K_) / 64) * ((N_) / 64); for (; it < n_it; it += NGW) p0_transpose_item128((W), (N_), (WT), (LDT), (GK), (SN), scr, it, lane); it -= n_it; }
        { const int n_it = (DM / 64) * (INW / 64); for (; it < n_it; it += NGW) p0_transpose_item128_f8(p.w_in, INW, Win8, DM, 64.0f, scr, it, lane); it -= n_it; }
        TJOB(p.w_branch_sb, SBW, DM, Wsb_t, SBW, nullptr, nullptr)
        { const int n_it = (PLW / 64) * (DM / 64); for (; it < n_it; it += NGW) p0_transpose_item128_f8(p.w_branch_pool, DM, (unsigned char*)Wpool_t, PLW, WBR_SC, scr, it, lane); it -= n_it; }
        { const int n_it = (DM / 64) * (DM / 64); for (; it < n_it; it += NGW) p0_transpose_item128_f8(p.w_out, DM, (unsigned char*)Wout_t, DM, WBR_SC, scr, it, lane); it -= n_it; }
        TJOB(p.xa_w_q, DM, XAW, Wxq_t, DM, p.norm_mem_q, nullptr)
        TJOB(p.xa_w_kv, DM, 2 * XAW, Wkv_t, DM, nullptr, nullptr)
        TJOB(p.xa_w_o, XAW, DM, Wxo_t, XAW, nullptr, nullptr)
        TJOB(p.peer_w_query, DM, PQW, Wpq_t, DM, p.norm_ffn, nullptr)
#pragma unroll 1
        for (int g = 0; g < 4; ++g) TJOB(p.pool_group_w + (size_t)g * 512 * 512, 512, 512, gw_t + (size_t)g * 512 * 512, 512, nullptr, p.pool_scale + g * 512)
#undef TJOB
        for (int m = gw; m < SEQ; m += NGW) rms_row_to_fp8(p.x + (size_t)m * DM, p.norm_mix, h1_8 + (size_t)m * DM, lane);
        for (int m = gw; m < MEML; m += NGW) rms_row_to_bf16(p.mem + (size_t)m * DM, p.norm_mem_kv, mem_n + (size_t)m * DM, lane);
        const size_t gtid = (size_t)vcu * 512 + tid, nthr = (size_t)G * 512;
        p0_convert(p.peer_sub_keys, keys_b, (size_t)PH * 2 * PKEYS * 128, gtid, nthr);
    }
    xcd_barrier(bar);
    PROBE_END

    PROBE_BEGIN(1)
    {
        pg8::Gemm g{(const bf16*)h1_8, (const bf16*)Win8, DM / 2, DM / 2, DM / 2}; pg8::Order<1> S; S.init(SEQ / 256, 56, 1, G, bx, (size_t)256 * DM, 0, (size_t)256 * DM, 0);
        pg8::EpiInProj E{qb, kb, ub, gsb, gpl, 1.0f / 64.0f};
        pg8::gemm_phase<pg8::EpiInProj, pg8::Order<1>, true>(lds, g, S, E, wave);
    }
    {
        pg8::Gemm g{(const bf16*)(Win8 + (size_t)2 * SBW * DM), (const bf16*)h1_8, DM / 2, DM / 2, DM / 2}; pg8::Order<0> S; S.init(SBW / 256, SEQ / 256, 1, G, bx, (size_t)256 * DM, 0, (size_t)256 * DM, 0);
        pg8::EpiB<0> E{vT, SEQ, nullptr, nullptr, nullptr, 1.0f / 64.0f};
        pg8::gemm_phase<pg8::EpiB<0>, pg8::Order<0>, true>(lds, g, S, E, wave);
    }
    xcd_barrier(bar);
    PROBE_END

    PROBE_BEGIN(2)
    {
        pg8::Gemm g{mem_n, Wkv_t, DM, DM, 256}; pg8::Order<0> S; S.init(1, 4, 16, G, bx, 0, 512, (size_t)256 * DM * 2, 512);
        pg8::EpiSlab E{kvs, 2 * XAW, (size_t)MEML * 2 * XAW};
        pg8::gemm_phase(lds, g, S, E, wave);
    }
    if (wave < 4) {
        FRESH_IDS();
        const int gw4 = vcu * 4 + wave, NGW4 = G * 4;
        for (int it = gw4; it < NH * (SEQ / 32); it += NGW4) sb_attn_item(qb, kb, vT, attn, it / (SEQ / 32), it % (SEQ / 32), lane);
        for (int it = gw4; it < (SEQ / 16) * 4; it += NGW4) { const int grp = it & 3, t0 = (it >> 2) * 16, cb = grp * 512;
            if (grp == 0) pool_item<2>(ub, pooled, t0, cb, lane); else if (grp == 1) pool_item<4>(ub, pooled, t0, cb, lane);
            else if (grp == 2) pool_item<8>(ub, pooled, t0, cb, lane); else pool_item<16>(ub, pooled, t0, cb, lane); }
    } else {
        FRESH_IDS();
        const int gw4 = vcu * 4 + (wave - 4), NGW4 = G * 4;
        {
#define QSRC(e_) (((e_) < NEXP) ? p.peer_down + (size_t)(e_) * DM : p.peer_up + (size_t)((e_) - NEXP) * DM)
#define QSCL(e_) (((e_) < NEXP) ? sdown + (e_) : sup + ((e_) - NEXP))
#define QSTORE(v_, e_) do { if ((e_) < NEXP) p0_quant_store(v_, down4 + (size_t)(e_) * ROW4, down6 + (size_t)(e_) * ROW6, QSCL(e_), lane); else p0_quant_store(v_, up4 + (size_t)((e_) - NEXP) * ROW4, up6 + (size_t)((e_) - NEXP) * ROW6, QSCL(e_), lane, up2 + (size_t)((e_) - NEXP) * ROW2, sup2 + ((e_) - NEXP), up1 + (size_t)((e_) - NEXP) * ROW1, sup1 + ((e_) - NEXP)); } while (0)
            f32x4 va[4][4], vb[4][4]; int e = gw4;
            if (e < 2 * NEXP) p0_quant_load(QSRC(e), va, lane);
            for (; e < 2 * NEXP; e += 2 * NGW4) {
                if (e + NGW4 < 2 * NEXP) p0_quant_load(QSRC(e + NGW4), vb, lane);
                QSTORE(va, e);
                if (e + 2 * NGW4 < 2 * NEXP) p0_quant_load(QSRC(e + 2 * NGW4), va, lane);
                if (e + NGW4 < 2 * NEXP) QSTORE(vb, e + NGW4);
            }
#undef QSRC
#undef QSCL
#undef QSTORE
        }
    }
    xcd_barrier(bar);
    PROBE_END

    PROBE_BEGIN(3)
    {
        FRESH_IDS();
        const size_t gtid = (size_t)vcu * 512 + tid, nthr = (size_t)G * 512;
        for (size_t i = gtid; i < (size_t)MEML * 2 * XAW; i += nthr) { float s = 0.f;
#pragma unroll
            for (int k = 0; k < 16; ++k) s += kvs[(size_t)k * MEML * 2 * XAW + i];
            const int m = (int)(i / (2 * XAW)), c = (int)(i % (2 * XAW)); const unsigned short b = (unsigned short)(cvt_pk_bf16(s, 0.f) & 0xffffu);
            if (c < XAW) kvk[(size_t)((c / HD) * MEML + m) * HD + (c % HD)] = b; else { const int cc = c - XAW; kvT[(size_t)((cc / HD) * HD + (cc % HD)) * MEML + m] = b; } }
    }
    {
        pg8::Gemm g{pooled, gw_t, PLW, 512, 512}; pg8::Order<2> S; S.init(SEQ / 256, PLW / 256, 1, G, bx, (size_t)256 * PLW * 2, 0, (size_t)256 * 512 * 2, 0);
        pg8::EpiB<4> E{mixed, PLW, nullptr, nullptr, nullptr, MIXED_SC};
        pg8::gemm_phase(lds, g, S, E, wave);
    }
    {
        pg8::Gemm g{attn, Wsb_t, SBW, SBW, SBW}; pg8::Order<0> S; S.init(SEQ / 256, DM / 256, 1, G, bx, (size_t)256 * SBW * 2, 0, (size_t)256 * SBW * 2, 0);
        pg8::EpiB<2> E{Tb, DM, nullptr, gsb, nullptr, 1.0f};
        pg8::gemm_phase(lds, g, S, E, wave);
    }
    xcd_barrier(bar);
    PROBE_END

    PROBE_BEGIN(4)
    {
        pg8::Gemm g{mixed, Wpool_t, PLW / 2, PLW / 2, PLW / 2}; pg8::Order<0> S; S.init(SEQ / 256, DM / 256, 1, G, bx, (size_t)256 * PLW, 0, (size_t)256 * PLW, 0);
        pg8::EpiB<5> E{gated, DM, nullptr, gpl, Tb, 1.0f / (MIXED_SC * WBR_SC), GATED_SC};
        pg8::gemm_phase<pg8::EpiB<5>, pg8::Order<0>, true>(lds, g, S, E, wave);
    }
    xcd_barrier(bar);
    PROBE_END

    {
        pg8::Gemm g{gated, Wout_t, DM / 2, DM / 2, DM / 2}; pg8::Order<0> S; S.init(SEQ / 256, DM / 256, 1, G, bx, (size_t)256 * DM, 0, (size_t)256 * DM, 0);
        pg8::EpiRes<false> E{p.x, nullptr, xb, ss2, 1.0f / (GATED_SC * WBR_SC)};
        pg8::gemm_phase<pg8::EpiRes<false>, pg8::Order<0>, true>(lds, g, S, E, wave);
    }
    xcd_barrier(bar);

    PROBE_BEGIN(6)
    {
        pg8::Gemm g{xb, Wxq_t, DM, DM, 1024}; pg8::Order<0> S; S.init(SEQ / 256, XAW / 256, 4, G, bx, (size_t)256 * DM * 2, 2048, (size_t)256 * DM * 2, 2048);
        pg8::EpiSlab E{xqs, XAW, (size_t)SEQ * XAW};
        pg8::gemm_phase(lds, g, S, E, wave);
    }
    xcd_barrier(bar);
    PROBE_END
    PROBE_BEGIN(7)
    {
        FRESH_IDS();
        const int h = bx & 3, j = bx >> 2, NJ = (G + 3 - h) >> 2;
        for (int idx = tid; idx < MEML * 16; idx += 512) { const int row = idx >> 4, c = idx & 15; *(LAS u32x4*)(lds + row * XK_STRIDE + c * 16) = *(const u32x4*)(kvk + (size_t)(h * MEML + row) * HD + c * 8); }
        for (int idx = tid; idx < HD * 32; idx += 512) { const int row = idx >> 5, c = idx & 31; const u32x4 v = *(const u32x4*)(kvT + (size_t)(h * HD + row) * MEML + c * 8);
            LAS u32x2* d = (LAS u32x2*)(lds + XV_OFF + row * XV_STRIDE + c * 16); d[0] = (u32x2){v.x, v.y}; d[1] = (u32x2){v.z, v.w}; }
        __syncthreads();
        for (int tt = j + NJ * wave; tt < SEQ / 32; tt += NJ * 8) xattn_item(xqs, ss2, lds, lds + XV_OFF, ob, h, tt, lane);
    }
    xcd_barrier(bar);
    PROBE_END
    {
        pg8::Gemm g{ob, Wxo_t, XAW, XAW, XAW}; pg8::Order<0> S; S.init(SEQ / 256, DM / 256, 1, G, bx, (size_t)256 * XAW * 2, 0, (size_t)256 * XAW * 2, 0);
        pg8::EpiRes<true> E{nullptr, xb, xb, ss3};
        pg8::gemm_phase(lds, g, S, E, wave);
    }
    xcd_barrier(bar);

    PROBE_BEGIN(9)
    {
        pg8::Gemm g{xb, Wpq_t, DM, DM, DM}; pg8::Order<0> S; S.init(SEQ / 256, PQW / 256, 1, G, bx, (size_t)256 * DM * 2, 0, (size_t)256 * DM * 2, 0);
        pg8::EpiB<1> E{pqb, PQW, ss3, nullptr, nullptr, 1.0f};
        pg8::gemm_phase(lds, g, S, E, wave);
    }
    xcd_barrier(bar);
    PROBE_END
    PROBE_BEGIN(10)
    { FRESH_IDS(); for (int it = vcu * 8 + wave; it < PH * (SEQ / 32); it += NGW) route_item(pqb, keys_b, eid, gate, it % PH, it / PH, lane); }
    xcd_barrier(bar);
    PROBE_END
    { const bool poisoned = xb_ld(ctl + CW_BAR + XB_TMO) != 0u;
      for (int t = gw; t < SEQ; t += NGW) { const int lane = fresh_lane();
          peer_token(xb + (size_t)t * DM, ss3[t], p.norm_ffn, p.norm_final, down4, down6, up4, up6, up2, up1, sdown, sup, sup2, sup1, eid + (size_t)t * 128, gate + (size_t)t * 128, p.out + (size_t)t * DM, lane);
          if (poisoned) p.out[(size_t)t * DM + lane] = __builtin_nanf(""); } }
}

extern "C" void kernel_launch(void* const* d_in, const int* in_sizes, int n_in, void* d_out, int out_size, void* d_ws, size_t ws_size, hipStream_t stream) {
    static int grid = 0;
    if (grid == 0) {
        if (n_in != 20 || out_size != SEQ * DM || ws_size < WS_END) { fprintf(stderr, "kernel_launch: unexpected problem (n_in %d, out %d, ws %zu)\n", n_in, out_size, ws_size); grid = -1; return; }
        int dev = 0, cus = 0, per_cu = 0;
        if (hipGetDevice(&dev) != hipSuccess || hipDeviceGetAttribute(&cus, hipDeviceAttributeMultiprocessorCount, dev) != hipSuccess) { grid = -1; return; }
        if (hipFuncSetAttribute((const void*)fwd, hipFuncAttributeMaxDynamicSharedMemorySize, LDS_BYTES) != hipSuccess) { fprintf(stderr, "kernel_launch: hipFuncSetAttribute failed\n"); grid = -1; return; }
        if (hipOccupancyMaxActiveBlocksPerMultiprocessor(&per_cu, (const void*)fwd, 512, LDS_BYTES) != hipSuccess || per_cu < 1) fprintf(stderr, "kernel_launch: occupancy query reports %d\n", per_cu);
        (void)hipGetLastError();
        grid = cus;
    }
    if (grid < 0) return;
    if (hipMemsetAsync((char*)d_ws + WS_CTL, 0, CTL_BYTES, stream) != hipSuccess) return;
    Params p{};
    const float** pp = (const float**)&p;
    for (int i = 0; i < 20; ++i) pp[i] = (const float*)d_in[i];
    p.out = (float*)d_out; p.ws = (unsigned char*)d_ws;
    hipLaunchKernelGGL(fwd, dim3(grid), dim3(512), LDS_BYTES, stream, p);
}
```
